# Optimizing an MI355X kernel written in HIP

```python
import math
import jax
import jax.numpy as jnp
from jax import lax
import numpy as np


D_MODEL = 1024
BATCH = 4
SEQ = 8192
DEPTH = 4

HEAD_DIM = 64
A_HEADS = 4
A_WIDTH = A_HEADS * HEAD_DIM
DILATED_PATTERNS = ((128, 1), (512, 4), (2048, 16))
ALIBI_MAX_EXP = 8.0
B_HEADS = 6
B_Q_RANK = 256
B_KV_RANK = 128
B_NOPE = 64
B_ROPE = 32
B_V = 64
B_QK = B_NOPE + B_ROPE
B_WIDTH = B_HEADS * B_V
C_HEADS = 6
C_KV_HEADS = 2
C_WIDTH = C_HEADS * HEAD_DIM
C_KV_WIDTH = C_KV_HEADS * HEAD_DIM
MIX_WIDTH = A_WIDTH + B_WIDTH + C_WIDTH

GRID_W = 64
ROPE_THETA = 10000.0
Q_BLOCK = 128
NORM_EPS = 1e-6
MASK_VALUE = -1e30

IN_SPLITS = (A_WIDTH, A_WIDTH, A_WIDTH, A_WIDTH,
             B_Q_RANK, B_KV_RANK, B_ROPE, B_WIDTH,
             C_WIDTH, C_KV_WIDTH, C_KV_WIDTH, C_WIDTH)
IN_COLS = sum(IN_SPLITS)

kernel_name = 'hybrid_dilated_mla_axial_gqa_encoder'


def rms_norm(x, g):
    x32 = x.astype(jnp.float32)
    y = x32 * lax.rsqrt(jnp.mean(x32 * x32, axis=-1, keepdims=True) + NORM_EPS)
    return (y * g.astype(jnp.float32)).astype(x.dtype)


def rope(x, pos):
    dr = x.shape[-1]
    half = dr // 2
    freqs = ROPE_THETA ** (-2.0 * jnp.arange(half, dtype=jnp.float32) / dr)
    ang = pos.astype(jnp.float32)[:, None] * freqs[None, :]
    cos = jnp.cos(ang)[:, None, :]
    sin = jnp.sin(ang)[:, None, :]
    x1 = x[..., :half].astype(jnp.float32)
    x2 = x[..., half:].astype(jnp.float32)
    return jnp.concatenate([x1 * cos - x2 * sin, x2 * cos + x1 * sin], axis=-1).astype(x.dtype)


def split_cols(proj):
    parts = []
    off = 0
    for w in IN_SPLITS:
        parts.append(proj[..., off:off + w])
        off += w
    return parts


def dense_attention(q, k, v):
    B, S, Hq, dk = q.shape
    Hkv = k.shape[2]
    G = Hq // Hkv
    dv = v.shape[-1]
    nblk = S // Q_BLOCK
    scale = dk ** -0.5
    qb = q.reshape(B, nblk, Q_BLOCK, Hkv, G, dk).transpose(1, 0, 2, 3, 4, 5)

    def one_block(qblk):
        s = jnp.einsum('bqkgd,bskd->bkgqs', qblk, k, preferred_element_type=jnp.float32) * scale
        p = jax.nn.softmax(s, axis=-1).astype(v.dtype)
        return jnp.einsum('bkgqs,bskd->bqkgd', p, v)

    out = lax.map(one_block, qb)
    return out.transpose(1, 0, 2, 3, 4, 5).reshape(B, S, Hq * dv)


def dilated_attention(q, k, v, slopes):
    B, S, H, hd = q.shape
    scale = hd ** -0.5
    outs = []
    lses = []
    for window, dil in DILATED_PATTERNS:
        half = window // (2 * dil)
        L = S // dil
        nb = -(-L // half)
        pad = nb * half - L

        def by_residue(a):
            return a.reshape(B, L, dil, H, hd)

        qd = jnp.pad(by_residue(q), ((0, 0), (0, pad), (0, 0), (0, 0), (0, 0)))
        qd = qd.reshape(B, nb, half, dil, H, hd)
        kp = jnp.pad(by_residue(k), ((0, 0), (half, pad + half), (0, 0), (0, 0), (0, 0)))
        vp = jnp.pad(by_residue(v), ((0, 0), (half, pad + half), (0, 0), (0, 0), (0, 0)))
        kp = kp.reshape(B, nb + 2, half, dil, H, hd)
        vp = vp.reshape(B, nb + 2, half, dil, H, hd)
        kw = jnp.concatenate([kp[:, :-2], kp[:, 1:-1], kp[:, 2:]], axis=2)
        vw = jnp.concatenate([vp[:, :-2], vp[:, 1:-1], vp[:, 2:]], axis=2)

        s = jnp.einsum('bnidhe,bnjdhe->bndhij', qd, kw, preferred_element_type=jnp.float32) * scale
        qi = jnp.arange(half)
        kj = jnp.arange(3 * half) - half
        delta = kj[None, :] - qi[:, None]
        key_pos = jnp.arange(nb)[:, None] * half + kj[None, :]
        valid = (jnp.abs(delta) <= half)[None] & ((key_pos >= 0) & (key_pos < L))[:, None, :]
        dist = (jnp.abs(delta) * dil).astype(jnp.float32)
        bias = -slopes[:, None, None] * dist[None]
        s = s + bias[None, None, None]
        s = jnp.where(valid[None, :, None, None], s, MASK_VALUE)
        m = jnp.max(s, axis=-1, keepdims=True)
        p = jnp.exp(s - m)
        den = jnp.sum(p, axis=-1, keepdims=True)
        o = jnp.einsum('bndhij,bnjdhe->bnidhe', (p / den).astype(v.dtype), vw)
        lse = (m + jnp.log(den))[..., 0]
        o = o.reshape(B, nb * half, dil, H, hd)[:, :L].reshape(B, S, H, hd)
        lse = lse.transpose(0, 1, 4, 2, 3).reshape(B, nb * half, dil, H)[:, :L].reshape(B, S, H)
        outs.append(o.astype(jnp.float32))
        lses.append(lse)
    w = jax.nn.softmax(jnp.stack(lses, axis=0), axis=0)
    out = jnp.sum(w[..., None] * jnp.stack(outs, axis=0), axis=0)
    return out.astype(q.dtype)


def setup_inputs(seed: int = 0) -> dict:
    key = jax.random.key(seed)
    ks = jax.random.split(key, 16)

    def nrm(k, shape, scale):
        return jax.random.normal(k, shape, jnp.float32) * scale

    def gain(k, shape):
        return 1.0 + 0.02 * jax.random.normal(k, shape, jnp.float32)

    return {
        'x': jax.random.normal(ks[0], (BATCH, SEQ, D_MODEL), jnp.float32),
        'norm_g': gain(ks[1], (DEPTH, D_MODEL)),
        'w_in': nrm(ks[2], (DEPTH, D_MODEL, IN_COLS), D_MODEL ** -0.5),
        'a_q_norm_g': gain(ks[3], (DEPTH, HEAD_DIM)),
        'a_k_norm_g': gain(ks[4], (DEPTH, HEAD_DIM)),
        'b_q_lat_norm_g': gain(ks[5], (DEPTH, B_Q_RANK)),
        'b_kv_lat_norm_g': gain(ks[6], (DEPTH, B_KV_RANK)),
        'w_b_q_up': nrm(ks[7], (DEPTH, B_Q_RANK, B_HEADS * B_QK), B_Q_RANK ** -0.5),
        'w_b_kv_up': nrm(ks[8], (DEPTH, B_KV_RANK, B_HEADS * (B_NOPE + B_V)), B_KV_RANK ** -0.5),
        'b_q_norm_g': gain(ks[9], (DEPTH, B_QK)),
        'b_k_norm_g': gain(ks[10], (DEPTH, B_QK)),
        'c_q_norm_g': gain(ks[11], (DEPTH, HEAD_DIM)),
        'c_k_norm_g': gain(ks[12], (DEPTH, HEAD_DIM)),
        'w_out': nrm(ks[13], (DEPTH, MIX_WIDTH, D_MODEL), MIX_WIDTH ** -0.5),
    }


def reference(x, norm_g, w_in, a_q_norm_g, a_k_norm_g, b_q_lat_norm_g, b_kv_lat_norm_g,
              w_b_q_up, w_b_kv_up, b_q_norm_g, b_k_norm_g, c_q_norm_g, c_k_norm_g, w_out):
    B, S, _ = x.shape
    t = jnp.arange(S)
    n_rows = S // GRID_W
    row = jnp.repeat(jnp.arange(n_rows), GRID_W)
    col = jnp.tile(jnp.arange(GRID_W), n_rows)
    slopes = 2.0 ** (-ALIBI_MAX_EXP * jnp.arange(1, A_HEADS + 1, dtype=jnp.float32) / A_HEADS)
    half_c = HEAD_DIM // 2

    for l in range(DEPTH):
        h = rms_norm(x, norm_g[l])
        proj = h @ w_in[l]
        (aq, ak, av, ag, bq_lat, bkv_lat, bk_pe, bg, cq, ck, cv, cg) = split_cols(proj)

        qa = rms_norm(aq.reshape(B, S, A_HEADS, HEAD_DIM), a_q_norm_g[l])
        ka = rms_norm(ak.reshape(B, S, A_HEADS, HEAD_DIM), a_k_norm_g[l])
        va = av.reshape(B, S, A_HEADS, HEAD_DIM)
        ya = dilated_attention(qa, ka, va, slopes).reshape(B, S, A_WIDTH) * jax.nn.silu(ag)

        qb = (rms_norm(bq_lat, b_q_lat_norm_g[l]) @ w_b_q_up[l]).reshape(B, S, B_HEADS, B_QK)
        kvb = (rms_norm(bkv_lat, b_kv_lat_norm_g[l]) @ w_b_kv_up[l]).reshape(B, S, B_HEADS, B_NOPE + B_V)
        k_nope = kvb[..., :B_NOPE]
        vb = kvb[..., B_NOPE:]
        k_pe = jnp.broadcast_to(bk_pe[:, :, None, :], (B, S, B_HEADS, B_ROPE))
        qb = rms_norm(qb, b_q_norm_g[l])
        kb = rms_norm(jnp.concatenate([k_nope, k_pe], axis=-1), b_k_norm_g[l])
        qb = jnp.concatenate([qb[..., :B_NOPE], rope(qb[..., B_NOPE:], t)], axis=-1)
        kb = jnp.concatenate([kb[..., :B_NOPE], rope(kb[..., B_NOPE:], t)], axis=-1)
        yb = dense_attention(qb, kb, vb) * jax.nn.silu(bg)

        qc = rms_norm(cq.reshape(B, S, C_HEADS, HEAD_DIM), c_q_norm_g[l])
        kc = rms_norm(ck.reshape(B, S, C_KV_HEADS, HEAD_DIM), c_k_norm_g[l])
        vc = cv.reshape(B, S, C_KV_HEADS, HEAD_DIM)
        qc = jnp.concatenate([rope(qc[..., :half_c], row), rope(qc[..., half_c:], col)], axis=-1)
        kc = jnp.concatenate([rope(kc[..., :half_c], row), rope(kc[..., half_c:], col)], axis=-1)
        yc = dense_attention(qc, kc, vc) * jax.nn.silu(cg)

        y = jnp.concatenate([ya, yb, yc], axis=-1)
        x = x + y @ w_out[l]
    return x
```

```cpp
#include <hip/hip_runtime.h>
#include <hip/hip_cooperative_groups.h>
#include <stdint.h>
#include <cstdio>
namespace cg = cooperative_groups;

typedef __attribute__((ext_vector_type(8))) short bf16x8;
typedef __attribute__((ext_vector_type(4))) short s16x4;
typedef __attribute__((ext_vector_type(16))) float f32x16;
typedef __attribute__((ext_vector_type(2))) float f32x2;
typedef __attribute__((ext_vector_type(2))) __bf16 bf2;
typedef __attribute__((ext_vector_type(4))) unsigned u32x4;
typedef unsigned short u16;

#define DI __device__ __forceinline__
#define MFMA32(a, b, c) __builtin_amdgcn_mfma_f32_32x32x16_bf16((a), (b), (c), 0, 0, 0)

constexpr int S = 8192, T = 32768, DEPTH = 4;
constexpr int NIN = 2848, NINP = 2944;
constexpr float EPS = 1e-6f;
constexpr int NTH = 512, NWV = 8;
constexpr float LOG2E = 1.4426950408889634f;
constexpr float QSCALE64 = 0.125f * LOG2E;
constexpr float QSCALE96 = 0.10206207261596575f * LOG2E;
#ifndef NPHASE
#define NPHASE 17
#endif
#ifndef COOP
#define COOP 1
#endif

constexpr size_t al256(size_t x) { return (x + 255) & ~(size_t)255; }
constexpr size_t OFF_WinT = 0;
constexpr size_t OFF_WoutT = OFF_WinT + al256((size_t)DEPTH * NINP * 1024 * 2);
constexpr size_t OFF_WqupT = OFF_WoutT + al256((size_t)DEPTH * 1024 * 1024 * 2);
constexpr size_t OFF_WkvupT = OFF_WqupT + al256((size_t)DEPTH * 576 * 256 * 2);
constexpr size_t OFF_xg = OFF_WkvupT + al256((size_t)DEPTH * 768 * 128 * 2);
constexpr size_t OFF_sumsq = OFF_xg + al256((size_t)T * 1024 * 2);
constexpr size_t OFF_rope = OFF_sumsq + al256((size_t)12 * T * 4);
constexpr size_t OFF_Qa = OFF_rope + al256((size_t)8192 * 16 * 8);
constexpr size_t OFF_Ka = OFF_Qa + al256((size_t)T * 256 * 2);
constexpr size_t OFF_Va = OFF_Ka + al256((size_t)T * 256 * 2);
constexpr size_t OFF_Gate = OFF_Va + al256((size_t)T * 256 * 2);
constexpr size_t OFF_qlat = OFF_Gate + al256((size_t)T * 1024 * 2);
constexpr size_t OFF_kvlat = OFF_qlat + al256((size_t)T * 256 * 2);
constexpr size_t OFF_R = OFF_kvlat + al256((size_t)T * 128 * 2);
constexpr size_t OFF_kpess = OFF_R + al256((size_t)T * 32 * 4);
constexpr size_t OFF_Qb = OFF_kpess + al256((size_t)T * 4);
constexpr size_t OFF_Kb = OFF_Qb + al256((size_t)T * 576 * 2);
constexpr size_t OFF_Vb = OFF_Kb + al256((size_t)T * 576 * 2);
constexpr size_t OFF_Qc = OFF_Vb + al256((size_t)T * 384 * 2);
constexpr size_t OFF_Kc = OFF_Qc + al256((size_t)T * 384 * 2);
constexpr size_t OFF_Vc = OFF_Kc + al256((size_t)T * 128 * 2);
constexpr size_t OFF_PartA = OFF_Vc + al256((size_t)T * 128 * 2);
constexpr size_t OFF_lA = OFF_PartA + al256((size_t)3 * T * 256 * 2);
constexpr size_t OFF_y = OFF_lA + al256((size_t)3 * T * 4 * 4);
constexpr size_t OFF_bar = OFF_y + al256((size_t)T * 1024 * 2);
constexpr size_t WS_TOTAL = OFF_bar + 16384;

#define AS1 __attribute__((address_space(1)))
struct KArgs {
  const float AS1* in[14];
  float AS1* out;
  char AS1* ws;
};
struct Params {
  const float* x; const float* norm_g; const float* w_in; const float* aq_g; const float* ak_g;
  const float* bql_g; const float* bkvl_g; const float* w_qup; const float* w_kvup;
  const float* bq_g; const float* bk_g; const float* cq_g; const float* ck_g; const float* w_out;
  float* out;
  u16* WinT; u16* WoutT; u16* WqupT; u16* WkvupT;
  u16* xg; float* sumsq_x; float* ss_ql; float* ss_kvl;
  float2* rope;
  u16* Qa; u16* Ka; u16* Va; u16* Gate; u16* qlat; u16* kvlat; float* R; float* kpe_ss;
  u16* Qb; u16* Kb; u16* Vb; u16* Qc; u16* Kc; u16* Vc; u16* PartA; float* lA; u16* y;
};
DI Params make_params(const KArgs& a) {
  Params p;
#define GP(i) ((const float*)a.in[i])
  p.x = GP(0); p.norm_g = GP(1); p.w_in = GP(2); p.aq_g = GP(3); p.ak_g = GP(4); p.bql_g = GP(5); p.bkvl_g = GP(6);
  p.w_qup = GP(7); p.w_kvup = GP(8); p.bq_g = GP(9); p.bk_g = GP(10); p.cq_g = GP(11); p.ck_g = GP(12); p.w_out = GP(13);
#undef GP
  p.out = (float*)a.out;
  char AS1* wg = a.ws; asm volatile("" : "+s"(wg));
  char* w = (char*)wg;
  p.WinT = (u16*)(w + OFF_WinT); p.WoutT = (u16*)(w + OFF_WoutT); p.WqupT = (u16*)(w + OFF_WqupT); p.WkvupT = (u16*)(w + OFF_WkvupT);
  p.xg = (u16*)(w + OFF_xg); p.sumsq_x = (float*)(w + OFF_sumsq); p.ss_ql = p.sumsq_x + 4 * T; p.ss_kvl = p.sumsq_x + 8 * T;
  p.rope = (float2*)(w + OFF_rope);
  p.Qa = (u16*)(w + OFF_Qa); p.Ka = (u16*)(w + OFF_Ka); p.Va = (u16*)(w + OFF_Va); p.Gate = (u16*)(w + OFF_Gate);
  p.qlat = (u16*)(w + OFF_qlat); p.kvlat = (u16*)(w + OFF_kvlat); p.R = (float*)(w + OFF_R); p.kpe_ss = (float*)(w + OFF_kpess);
  p.Qb = (u16*)(w + OFF_Qb); p.Kb = (u16*)(w + OFF_Kb); p.Vb = (u16*)(w + OFF_Vb);
  p.Qc = (u16*)(w + OFF_Qc); p.Kc = (u16*)(w + OFF_Kc); p.Vc = (u16*)(w + OFF_Vc);
  p.PartA = (u16*)(w + OFF_PartA); p.lA = (float*)(w + OFF_lA); p.y = (u16*)(w + OFF_y);
  return p;
}

DI unsigned pk(float a, float b) { f32x2 x = {a, b}; bf2 y = __builtin_convertvector(x, bf2); return __builtin_bit_cast(unsigned, y); }
DI float bflo(unsigned u) { return __uint_as_float(u << 16); }
DI float bfhi(unsigned u) { return __uint_as_float(u & 0xffff0000u); }
DI int otid() { int t = threadIdx.x; asm volatile("" : "+v"(t)); return t; }
DI int crow(int i, int h) { return (i & 3) + 8 * (i >> 2) + 4 * h; }
DI float xsum32(float v) { return v + __shfl_xor(v, 32, 64); }
DI void st4(u16* d, float a, float b, float c, float e) { *(uint2*)d = make_uint2(pk(a, b), pk(c, e)); }
DI bf16x8 pack8(float a0, float a1, float a2, float a3, float a4, float a5, float a6, float a7) {
  u32x4 w = {pk(a0, a1), pk(a2, a3), pk(a4, a5), pk(a6, a7)}; return __builtin_bit_cast(bf16x8, w);
}
DI int swz(int row, int ch) { return row * 128 + ((ch ^ ((row >> 1) & 7)) << 4); }
DI int voffc(int row, int ch) { return row * 128 + ((((ch >> 2) ^ (row >> 1)) & 1) << 6) + (ch & 3) * 16; }
DI s16x4 trread(const char* p) {
  return __builtin_amdgcn_ds_read_tr16_b64_v4i16((s16x4 __attribute__((address_space(3)))*)(p));
}
DI bf16x8 cat4(s16x4 lo, s16x4 hi) { return __builtin_shufflevector(lo, hi, 0, 1, 2, 3, 4, 5, 6, 7); }

DI int winmap(int n) { return n < 1408 ? n : (n < 2816 ? n + 32 : (n < 2848 ? n - 1408 : -1)); }

DI void wtrans_tile(const float* __restrict__ src, int ldsrc, u16* __restrict__ dst, int K, int k0, int n0, bool perm,
                    const float* __restrict__ rowscale, char* lds) {
  float* tile = (float*)lds;
  const int tid = otid();
  __syncthreads();
  const int c = tid & 63, r0 = tid >> 6;
  const int ncol = perm ? winmap(n0 + c) : (n0 + c);
#pragma unroll
  for (int i = 0; i < 8; ++i) {
    const int r = r0 + 8 * i;
    float v = ncol >= 0 ? src[(size_t)(k0 + r) * ldsrc + ncol] : 0.f;
    if (rowscale) v *= rowscale[k0 + r];
    tile[r * 65 + c] = v;
  }
  __syncthreads();
  {
    const int idx = tid, n = idx >> 3, ch = idx & 7;
    float e[8];
#pragma unroll
    for (int q = 0; q < 8; ++q) e[q] = tile[(ch * 8 + q) * 65 + n];
    *(bf16x8*)(dst + (size_t)(n0 + n) * K + k0 + ch * 8) = pack8(e[0], e[1], e[2], e[3], e[4], e[5], e[6], e[7]);
  }
}

DI void phaseW(const KArgs& ka, char* lds) {
  const Params p = make_params(ka);
  const int tid = otid(), nb = gridDim.x, bid = blockIdx.x;
  for (int i = bid * NTH + tid; i < 11 * T; i += nb * NTH) p.sumsq_x[T + i] = 0.f;
  for (int i = bid * NTH + tid; i < 8192 * 16; i += nb * NTH) {
    const int pos = i >> 4, j = i & 15;
    float fh = 1.f, fl = 0.f;
#pragma unroll
    for (int q = 1; q < 16; ++q) {
      constexpr double Bq[4] = {1.0, 0.5623413251903491, 0.31622776601683794, 0.1778279410038923};
      constexpr double Pq[4] = {1.0, 0.1, 0.01, 0.001};
      const double f = Bq[q & 3] * Pq[q >> 2];
      const float h_ = (float)f; const float l_ = (float)(f - (double)h_);
      if (j == q) { fh = h_; fl = l_; }
    }
    const float fp = (float)pos;
    const float a = fp * fh, e = fmaf(fp, fh, -a), alo = fmaf(fp, fl, e);
    const float k = rintf(a * 0.15915494309189535f);
    float r = fmaf(-k, 6.28125f, a);
    r = fmaf(-k, 0.0019340515136718750f, r);
    r = fmaf(-k, 1.2556659146020e-06f, r);
    r += alo;
    p.rope[i] = make_float2(cosf(r), sinf(r));
  }
  {
    const int wave = __builtin_amdgcn_readfirstlane(tid >> 6), lane = tid & 63;
    for (int row = bid * NWV + wave; row < T; row += nb * NWV) {
      const float* xr = p.x + (size_t)row * 1024;
      float ss = 0.f;
#pragma unroll
      for (int j = 0; j < 4; ++j) {
        const int c = lane * 4 + 256 * j;
        const float4 v = *(const float4*)(xr + c);
        const float4 g = *(const float4*)(p.norm_g + c);
        ss += v.x * v.x + v.y * v.y + v.z * v.z + v.w * v.w;
        st4(p.xg + (size_t)row * 1024 + c, v.x * g.x, v.y * g.y, v.z * g.z, v.w * g.w);
      }
#pragma unroll
      for (int o = 32; o >= 1; o >>= 1) ss += __shfl_xor(ss, o, 64);
      if (lane == 0) p.sumsq_x[row] = ss;
    }
  }
  constexpr int N_IN = DEPTH * 16 * 46, N_OUT = DEPTH * 16 * 16, N_QU = DEPTH * 4 * 9, N_KV = DEPTH * 2 * 12;
  for (int it = bid; it < N_IN + N_OUT + N_QU + N_KV; it += nb) {
    if (it < N_IN) {
      const int l = it / (16 * 46), r = it % (16 * 46), kt = r / 46, nt = r % 46;
      wtrans_tile(p.w_in + (size_t)l * 1024 * NIN, NIN, p.WinT + (size_t)l * NINP * 1024, 1024, kt * 64, nt * 64, true, nullptr, lds);
    } else if (it < N_IN + N_OUT) {
      const int i2 = it - N_IN, l = i2 / 256, r = i2 % 256, kt = r / 16, nt = r % 16;
      wtrans_tile(p.w_out + (size_t)l * 1024 * 1024, 1024, p.WoutT + (size_t)l * 1024 * 1024, 1024, kt * 64, nt * 64, false, nullptr, lds);
    } else if (it < N_IN + N_OUT + N_QU) {
      const int i2 = it - N_IN - N_OUT, l = i2 / 36, r = i2 % 36, kt = r / 9, nt = r % 9;
      wtrans_tile(p.w_qup + (size_t)l * 256 * 576, 576, p.WqupT + (size_t)l * 576 * 256, 256, kt * 64, nt * 64, false, p.bql_g + l * 256, lds);
    } else {
      const int i2 = it - N_IN - N_OUT - N_QU, l = i2 / 24, r = i2 % 24, kt = r / 12, nt = r % 12;
      wtrans_tile(p.w_kvup + (size_t)l * 128 * 768, 768, p.WkvupT + (size_t)l * 768 * 128, 128, kt * 64, nt * 64, false, p.bkvl_g + l * 128, lds);
    }
  }
}

struct ALoadPlain {
  const u16* A; int lda;
  DI bf16x8 operator()(int row, int kcol) const { return *(const bf16x8*)(A + (size_t)row * lda + kcol); }
};
struct ALoadY {
  const u16* y; const u16* part; const float* lA; const u16* gate;
  DI bf16x8 operator()(int row, int kcol) const {
    if (kcol >= 256) return *(const bf16x8*)(y + (size_t)row * 1024 + kcol);
    const int head = kcol >> 6;
    float o[8] = {0, 0, 0, 0, 0, 0, 0, 0}; float l = 0.f;
#pragma unroll
    for (int pt = 0; pt < 3; ++pt) {
      const uint4 u = *(const uint4*)(part + ((size_t)pt * T + row) * 256 + kcol);
      o[0] += bflo(u.x); o[1] += bfhi(u.x); o[2] += bflo(u.y); o[3] += bfhi(u.y);
      o[4] += bflo(u.z); o[5] += bfhi(u.z); o[6] += bflo(u.w); o[7] += bfhi(u.w);
      l += lA[((size_t)pt * T + row) * 4 + head];
    }
    const uint4 g = *(const uint4*)(gate + (size_t)row * 1024 + kcol);
    const float inv = 1.f / l;
    return pack8(o[0] * inv * bflo(g.x), o[1] * inv * bfhi(g.x), o[2] * inv * bflo(g.y), o[3] * inv * bfhi(g.y),
                 o[4] * inv * bflo(g.z), o[5] * inv * bfhi(g.z), o[6] * inv * bflo(g.w), o[7] * inv * bfhi(g.w));
  }
};

template <int NB>
DI void gemm_tile(const u16* __restrict__ A, int lda, const u16* __restrict__ Wt, int K, int m0, int n0, char* lds, f32x16 (&acc)[2][NB]) {
  const int tid = otid(), wave = __builtin_amdgcn_readfirstlane(tid >> 6), lane = tid & 63, r32 = lane & 31, h = lane >> 5;
  const int wm = wave >> 1, wn = wave & 1;
  constexpr int STG = 32768 + NB * 8192;
#pragma unroll
  for (int a = 0; a < 2; ++a)
#pragma unroll
    for (int b = 0; b < NB; ++b)
#pragma unroll
      for (int i = 0; i < 16; ++i) acc[a][b][i] = 0.f;
  const int nk = K >> 6;
  int asrc[4], wsrc[NB];
#pragma unroll
  for (int q = 0; q < 4; ++q) { const int P = (wave * 4 + q) * 64 + lane, row = P >> 3, cp = P & 7; asrc[q] = (m0 + row) * lda + ((cp ^ ((row >> 1) & 7)) << 3); }
#pragma unroll
  for (int q = 0; q < NB; ++q) { const int P = (wave * NB + q) * 64 + lane, row = P >> 3, cp = P & 7; wsrc[q] = (n0 + row) * K + ((cp ^ ((row >> 1) & 7)) << 3); }
  auto stage = [&](int kt, char* buf) {
#pragma unroll
    for (int q = 0; q < 4; ++q)
      __builtin_amdgcn_global_load_lds((const unsigned*)(A + (size_t)asrc[q] + kt * 64), (unsigned __attribute__((address_space(3)))*)(buf + (wave * 4 + q) * 1024), 16, 0, 0);
#pragma unroll
    for (int q = 0; q < NB; ++q)
      __builtin_amdgcn_global_load_lds((const unsigned*)(Wt + (size_t)wsrc[q] + kt * 64), (unsigned __attribute__((address_space(3)))*)(buf + 32768 + (wave * NB + q) * 1024), 16, 0, 0);
  };
  __syncthreads();
  stage(0, lds);
  asm volatile("s_waitcnt vmcnt(0)" ::: "memory");
  __syncthreads();
#pragma unroll 1
  for (int kt = 0; kt < nk; ++kt) {
    char* buf = lds + (kt & 1) * STG;
    char* nbuf = lds + ((kt + 1) & 1) * STG;
    if (kt + 1 < nk) stage(kt + 1, nbuf);
#pragma unroll
    for (int s = 0; s < 4; ++s) {
      bf16x8 af[2], wf[NB];
#pragma unroll
      for (int a = 0; a < 2; ++a) af[a] = *(const bf16x8*)(buf + swz(wm * 64 + a * 32 + r32, 2 * s + h));
#pragma unroll
      for (int b = 0; b < NB; ++b) wf[b] = *(const bf16x8*)(buf + 32768 + swz(wn * NB * 32 + b * 32 + r32, 2 * s + h));
#pragma unroll
      for (int a = 0; a < 2; ++a)
#pragma unroll
        for (int b = 0; b < NB; ++b) acc[a][b] = MFMA32(wf[b], af[a], acc[a][b]);
    }
    asm volatile("s_waitcnt vmcnt(0)" ::: "memory");
    __syncthreads();
  }
}

DI int swz64(int row, int ch) { return row * 64 + ((ch ^ ((row >> 2) & 3)) << 4); }
DI void gemm_tile4(const u16* __restrict__ A, int lda, const u16* __restrict__ Wt, int K, int m0, int n0, char* lds, f32x16 (&acc)[2][4]) {
  const int tid = otid(), wave = __builtin_amdgcn_readfirstlane(tid >> 6), lane = tid & 63, r32 = lane & 31, h = lane >> 5;
  const int wm = wave >> 1, wn = wave & 1;
  constexpr int STG = 16384 + 16384;
#pragma unroll
  for (int a = 0; a < 2; ++a)
#pragma unroll
    for (int b = 0; b < 4; ++b)
#pragma unroll
      for (int i = 0; i < 16; ++i) acc[a][b][i] = 0.f;
  const int nk = K >> 5;
  int asrc[2], wsrc[2];
#pragma unroll
  for (int q = 0; q < 2; ++q) { const int P = (wave * 2 + q) * 64 + lane, row = P >> 2, cp = P & 3; asrc[q] = (m0 + row) * lda + ((cp ^ ((row >> 2) & 3)) << 3); }
#pragma unroll
  for (int q = 0; q < 2; ++q) { const int P = (wave * 2 + q) * 64 + lane, row = P >> 2, cp = P & 3; wsrc[q] = (n0 + row) * K + ((cp ^ ((row >> 2) & 3)) << 3); }
  auto stage = [&](int kt, char* buf) {
#pragma unroll
    for (int q = 0; q < 2; ++q)
      __builtin_amdgcn_global_load_lds((const unsigned*)(A + (size_t)asrc[q] + kt * 32), (unsigned __attribute__((address_space(3)))*)(buf + (wave * 2 + q) * 1024), 16, 0, 0);
#pragma unroll
    for (int q = 0; q < 2; ++q)
      __builtin_amdgcn_global_load_lds((const unsigned*)(Wt + (size_t)wsrc[q] + kt * 32), (unsigned __attribute__((address_space(3)))*)(buf + 16384 + (wave * 2 + q) * 1024), 16, 0, 0);
  };
  __syncthreads();
  stage(0, lds); stage(1, lds + STG);
  bf16x8 af0[2], wf0[4], af1[2], wf1[4];
  auto rd = [&](const char* buf, int s, bf16x8 (&af)[2], bf16x8 (&wf)[4]) {
#pragma unroll
    for (int a = 0; a < 2; ++a) af[a] = *(const bf16x8*)(buf + swz64(wm * 64 + a * 32 + r32, 2 * s + h));
#pragma unroll
    for (int b = 0; b < 4; ++b) wf[b] = *(const bf16x8*)(buf + 16384 + swz64(wn * 128 + b * 32 + r32, 2 * s + h));
  };
  auto mm = [&](const bf16x8 (&af)[2], const bf16x8 (&wf)[4]) {
#pragma unroll
    for (int a = 0; a < 2; ++a)
#pragma unroll
      for (int b = 0; b < 4; ++b) acc[a][b] = MFMA32(wf[b], af[a], acc[a][b]);
  };
  int cur = 0;
#pragma unroll 1
  for (int kt = 0; kt < nk; ++kt) {
    if (kt + 1 < nk) asm volatile("s_waitcnt vmcnt(4)" ::: "memory"); else asm volatile("s_waitcnt vmcnt(0)" ::: "memory");
    asm volatile("s_waitcnt lgkmcnt(0)" ::: "memory"); __builtin_amdgcn_s_barrier(); asm volatile("" ::: "memory");
    const char* buf = lds + cur * STG;
    { const int nx2 = cur == 0 ? 2 : cur - 1; if (kt + 2 < nk) stage(kt + 2, lds + nx2 * STG); }
    rd(buf, 0, af0, wf0);
    if (kt > 0) mm(af1, wf1);
    rd(buf, 1, af1, wf1);
    mm(af0, wf0);
#ifndef NO_SGB4
    __builtin_amdgcn_sched_group_barrier(0x100, 6, 0);
    __builtin_amdgcn_sched_group_barrier(0x008, 8, 0);
    __builtin_amdgcn_sched_group_barrier(0x100, 6, 0);
    __builtin_amdgcn_sched_group_barrier(0x008, 8, 0);
#endif
    cur = cur == 2 ? 0 : cur + 1;
  }
  mm(af1, wf1);
  asm volatile("s_waitcnt lgkmcnt(0)" ::: "memory"); __builtin_amdgcn_s_barrier(); asm volatile("" ::: "memory");
}

constexpr int WREG = 20480;
DI void stg4(char* wl, int rs, int trow, int colbyte, float a, float b, float c, float e) {
  *(uint2*)(wl + trow * rs + colbyte) = make_uint2(pk(a, b), pk(c, e));
}
template <int CH>
DI void flush_rows(const char* wl, int rs, int lane, char* dst0, size_t dstride) {
  asm volatile("" : "+v"(lane));
#pragma unroll
  for (int j = 0; j < CH; ++j) {
    const int idx = j * 64 + lane, row = idx / CH, ch = idx % CH;
    const uint4 t = *(const uint4*)(wl + row * rs + ch * 16);
    *(uint4*)(dst0 + (size_t)row * dstride + ch * 16) = t;
  }
}
DI void epi_gemm1(const Params& p, int l, const f32x16& a0, const f32x16& a1, int token, int trow, int cb, int h, char* wl) {
  constexpr int RS = 144;
  const int sp = token & 8191;
  const float rs = rsqrtf(p.sumsq_x[l * T + token] * (1.f / 1024.f) + EPS);
  float v[2][16];
#pragma unroll
  for (int i = 0; i < 16; ++i) { v[0][i] = a0[i] * rs; v[1][i] = a1[i] * rs; }
  if (cb < 512 || (cb >= 1792 && cb < 2304)) {
    float ss = 0.f;
#pragma unroll
    for (int i = 0; i < 16; ++i) ss += v[0][i] * v[0][i] + v[1][i] * v[1][i];
    ss = xsum32(ss);
    const float r = rsqrtf(ss * (1.f / 64.f) + EPS);
    const float* g; float qs = 1.f; bool rope = false;
    if (cb < 256)       { g = p.aq_g + l * 64; qs = QSCALE64; }
    else if (cb < 512)  { g = p.ak_g + l * 64; }
    else if (cb < 2176) { g = p.cq_g + l * 64; qs = QSCALE64; rope = true; }
    else                { g = p.ck_g + l * 64; rope = true; }
    const float rq = r * qs;
#pragma unroll
    for (int nb = 0; nb < 2; ++nb)
#pragma unroll
      for (int g4 = 0; g4 < 4; ++g4) {
        const float4 gg = *(const float4*)(g + nb * 32 + 8 * g4 + 4 * h);
        v[nb][4 * g4] *= rq * gg.x; v[nb][4 * g4 + 1] *= rq * gg.y; v[nb][4 * g4 + 2] *= rq * gg.z; v[nb][4 * g4 + 3] *= rq * gg.w;
      }
    if (rope) {
#pragma unroll
      for (int nb = 0; nb < 2; ++nb) {
        const int pos = nb == 0 ? (sp >> 6) : (sp & 63);
#pragma unroll
        for (int i = 0; i < 8; ++i) {
          const float2 cs = p.rope[pos * 16 + crow(i, h)];
          const float x1 = v[nb][i], x2 = v[nb][i + 8];
          v[nb][i] = x1 * cs.x - x2 * cs.y; v[nb][i + 8] = x2 * cs.x + x1 * cs.y;
        }
      }
    }
  } else if ((cb >= 512 && cb < 768) || (cb >= 2304 && cb < 2432)) {
  } else if (cb >= 1024 && cb < 1408) {
    float ss = 0.f;
#pragma unroll
    for (int i = 0; i < 16; ++i) ss += v[0][i] * v[0][i] + v[1][i] * v[1][i];
    ss = xsum32(ss);
    if (h == 0) atomicAdd((cb < 1280 ? p.ss_ql : p.ss_kvl) + l * T + token, ss);
  } else if (cb == 2816) {
    float ss = 0.f;
#pragma unroll
    for (int i = 0; i < 16; ++i) ss += v[0][i] * v[0][i];
    ss = xsum32(ss);
    if (h == 0) p.kpe_ss[token] = ss;
    const float* g = p.bk_g + l * 96 + 64;
#pragma unroll
    for (int i = 0; i < 8; ++i) {
      const int j = crow(i, h);
      const float2 cs = p.rope[sp * 16 + j];
      const float x1 = v[0][i] * g[j], x2 = v[0][i + 8] * g[16 + j];
      v[0][i] = x1 * cs.x - x2 * cs.y; v[0][i + 8] = x2 * cs.x + x1 * cs.y;
    }
#pragma unroll
    for (int g4 = 0; g4 < 4; ++g4)
      *(float4*)(wl + trow * RS + (8 * g4 + 4 * h) * 4) = make_float4(v[0][4 * g4], v[0][4 * g4 + 1], v[0][4 * g4 + 2], v[0][4 * g4 + 3]);
    return;
  } else {
#pragma unroll
    for (int nb = 0; nb < 2; ++nb)
#pragma unroll
      for (int i = 0; i < 16; ++i) { const float x = v[nb][i]; v[nb][i] = x / (1.f + __expf(-x)); }
  }
#pragma unroll
  for (int nb = 0; nb < 2; ++nb)
#pragma unroll
    for (int g4 = 0; g4 < 4; ++g4)
      stg4(wl, RS, trow, (nb * 32 + 8 * g4 + 4 * h) * 2, v[nb][4 * g4], v[nb][4 * g4 + 1], v[nb][4 * g4 + 2], v[nb][4 * g4 + 3]);
}

DI void gemm1_flush(const Params& p, int cb, int token0, const char* wl, int lane) {
  const int b = token0 >> 13, sp0 = token0 & 8191;
  char* dst; size_t dstride;
  if (cb < 256)       { dst = (char*)(p.Qa + ((size_t)(b * 4 + (cb >> 6)) * S + sp0) * 64); dstride = 128; }
  else if (cb < 512)  { dst = (char*)(p.Ka + ((size_t)(b * 4 + ((cb - 256) >> 6)) * S + sp0) * 64); dstride = 128; }
  else if (cb < 768)  { dst = (char*)(p.Va + ((size_t)(b * 4 + ((cb - 512) >> 6)) * S + sp0) * 64); dstride = 128; }
  else if (cb < 1024) { dst = (char*)(p.Gate + (size_t)token0 * 1024 + (cb - 768)); dstride = 2048; }
  else if (cb < 1280) { dst = (char*)(p.qlat + (size_t)token0 * 256 + (cb - 1024)); dstride = 512; }
  else if (cb < 1408) { dst = (char*)(p.kvlat + (size_t)token0 * 128 + (cb - 1280)); dstride = 256; }
  else if (cb < 1792) { dst = (char*)(p.Gate + (size_t)token0 * 1024 + 256 + (cb - 1408)); dstride = 2048; }
  else if (cb < 2176) { dst = (char*)(p.Qc + ((size_t)(b * 6 + ((cb - 1792) >> 6)) * S + sp0) * 64); dstride = 128; }
  else if (cb < 2304) { dst = (char*)(p.Kc + ((size_t)(b * 2 + ((cb - 2176) >> 6)) * S + sp0) * 64); dstride = 128; }
  else if (cb < 2432) { dst = (char*)(p.Vc + ((size_t)(b * 2 + ((cb - 2304) >> 6)) * S + sp0) * 64); dstride = 128; }
  else if (cb < 2816) { dst = (char*)(p.Gate + (size_t)token0 * 1024 + 640 + (cb - 2432)); dstride = 2048; }
  else                { dst = (char*)(p.R + (size_t)token0 * 32); dstride = 128; }
  flush_rows<8>(wl, 144, lane, dst, dstride);
}

DI void phase_gemm1(const KArgs& ka, int l, char* lds) {
  const Params p = make_params(ka);
  const int tid = otid(), wave = __builtin_amdgcn_readfirstlane(tid >> 6), lane = tid & 63, r32 = lane & 31, h = lane >> 5;
  const int wm = wave >> 1, wn = wave & 1;
  const u16* Wt = p.WinT + (size_t)l * NINP * 1024;
  char* wl = lds + wave * WREG;
  const int xcd = blockIdx.x & 7, jb = blockIdx.x >> 3, nbx = gridDim.x >> 3;
  const int nrnd = (192 - jb + nbx - 1) / nbx;
  for (int ir = 0; ir < nrnd; ++ir) {
    const int kr = (jb >= (nbx >> 1)) ? (ir == 0 ? nrnd - 1 : ir - 1) : ir;
    const int q = jb + kr * nbx;
    const int mt = xcd * 16 + (q & 15), nt = q >> 4;
    const int token0 = mt * 256 + wm * 64;
    if (nt < 11) {
      f32x16 acc[2][4];
      gemm_tile<4>(p.xg, 1024, Wt, 1024, mt * 256, nt * 256, lds, acc);
#pragma unroll
      for (int hf = 0; hf < 2; ++hf) {
        const int cb = nt * 256 + wn * 128 + hf * 64;
#pragma unroll
        for (int a = 0; a < 2; ++a) epi_gemm1(p, l, acc[a][2 * hf], acc[a][2 * hf + 1], token0 + a * 32 + r32, a * 32 + r32, cb, h, wl);
        gemm1_flush(p, cb, token0, wl, lane);
      }
    } else {
      f32x16 acc[2][2];
      gemm_tile<2>(p.xg, 1024, Wt, 1024, mt * 256, 2816, lds, acc);
      const int cb = 2816 + wn * 64;
      if (cb >= 2880) continue;
#pragma unroll
      for (int a = 0; a < 2; ++a) epi_gemm1(p, l, acc[a][0], acc[a][1], token0 + a * 32 + r32, a * 32 + r32, cb, h, wl);
      gemm1_flush(p, cb, token0, wl, lane);
    }
  }
}

DI void attn_a_block(const Params& p, int b, int head, int pat, int grp, char* lds) {
  const int tid = otid(), wave = __builtin_amdgcn_readfirstlane(tid >> 6), lane = tid & 63, r32 = lane & 31, h = lane >> 5;
  const int sh = 2 * pat, dil = 1 << sh, L = S >> sh, L32s = 8 - sh;
  const int wi0 = grp * 8, r = wi0 >> L32s, lb0 = (wi0 & ((1 << L32s) - 1)) * 32;
  const int l0 = lb0 + wave * 32, lbase = lb0 - 64;
  const size_t hb = (size_t)(b * 4 + head) * S;
  const u16* Qh = p.Qa + hb * 64; const u16* Kh = p.Ka + hb * 64; const u16* Vh = p.Va + hb * 64;
  char* Kimg = lds; char* Vimg = lds + 384 * 128;
#pragma unroll
  for (int q = 0; q < 6; ++q) {
    const int P = (wave * 6 + q) * 64 + lane, row = P >> 3, cp = P & 7;
    int lk = lbase + row; lk = lk < 0 ? 0 : (lk >= L ? L - 1 : lk);
    const size_t tok = (size_t)((lk << sh) + r) * 64;
    __builtin_amdgcn_global_load_lds((const unsigned*)(Kh + tok + ((cp ^ ((row >> 1) & 7)) << 3)), (unsigned __attribute__((address_space(3)))*)(Kimg + (wave * 6 + q) * 1024), 16, 0, 0);
    __builtin_amdgcn_global_load_lds((const unsigned*)(Vh + tok + ((cp ^ (((row >> 1) & 1) << 2)) << 3)), (unsigned __attribute__((address_space(3)))*)(Vimg + (wave * 6 + q) * 1024), 16, 0, 0);
  }
  bf16x8 qf[4];
  const int tq = ((l0 + r32) << sh) + r;
#pragma unroll
  for (int s = 0; s < 4; ++s) qf[s] = *(const bf16x8*)(Qh + (size_t)tq * 64 + 16 * s + 8 * h);
  f32x16 O0, O1;
#pragma unroll
  for (int i = 0; i < 16; ++i) { O0[i] = 0.f; O1[i] = 0.f; }
  float ls = 0.f;
  const float slope2 = exp2f(-2.f * (float)(head + 1)) * (float)dil * LOG2E;
  const int i16 = lane & 15, qq = i16 >> 2, pp = i16 & 3, blk = (lane >> 4) & 1, sw = (qq >> 1) & 1;
  const int vb0 = (4 * h + qq) * 128 + ((0 ^ sw) << 6) + (16 * blk + 4 * pp) * 2;
  const int vb1 = (4 * h + qq) * 128 + ((1 ^ sw) << 6) + (16 * blk + 4 * pp) * 2;
  asm volatile("s_waitcnt vmcnt(0)" ::: "memory");
  __syncthreads();
#pragma unroll
  for (int kb = 0; kb < 5; ++kb) {
    const int rowb = wave * 32 + kb * 32;
    const int ks = l0 - 64 + 32 * kb;
    f32x16 Sx;
#pragma unroll
    for (int i = 0; i < 16; ++i) Sx[i] = 0.f;
#pragma unroll
    for (int s = 0; s < 4; ++s) {
      const bf16x8 kf = *(const bf16x8*)(Kimg + swz(rowb + r32, 2 * s + h));
      Sx = MFMA32(kf, qf[s], Sx);
    }
#pragma unroll
    for (int i = 0; i < 16; ++i) {
      const int lkey = ks + crow(i, h);
      const int dl = lkey - (l0 + r32);
      const int ad = dl < 0 ? -dl : dl;
      const bool valid = (ad <= 64) && (lkey >= 0) && (lkey < L);
      const float pv = valid ? __builtin_amdgcn_exp2f(Sx[i] - slope2 * (float)ad) : 0.f;
      ls += pv; Sx[i] = pv;
    }
    bf16x8 pf[2];
#pragma unroll
    for (int st = 0; st < 2; ++st)
      pf[st] = pack8(Sx[8 * st], Sx[8 * st + 1], Sx[8 * st + 2], Sx[8 * st + 3], Sx[8 * st + 4], Sx[8 * st + 5], Sx[8 * st + 6], Sx[8 * st + 7]);
#pragma unroll
    for (int st = 0; st < 2; ++st) {
      const char* v0 = Vimg + vb0 + (rowb + st * 16) * 128;
      const char* v1 = Vimg + vb1 + (rowb + st * 16) * 128;
      const bf16x8 vf0 = cat4(trread(v0), trread(v0 + 8 * 128));
      const bf16x8 vf1 = cat4(trread(v1), trread(v1 + 8 * 128));
      O0 = MFMA32(vf0, pf[st], O0);
      O1 = MFMA32(vf1, pf[st], O1);
    }
  }
  const float lt = xsum32(ls);
  const size_t token = (size_t)b * S + tq;
  u16* d = p.PartA + ((size_t)pat * T + token) * 256 + head * 64;
#pragma unroll
  for (int g4 = 0; g4 < 4; ++g4) {
    st4(d + 8 * g4 + 4 * h, O0[4 * g4], O0[4 * g4 + 1], O0[4 * g4 + 2], O0[4 * g4 + 3]);
    st4(d + 32 + 8 * g4 + 4 * h, O1[4 * g4], O1[4 * g4 + 1], O1[4 * g4 + 2], O1[4 * g4 + 3]);
  }
  if (h == 0) p.lA[((size_t)pat * T + token) * 4 + head] = lt;
}

DI void phase_mla_up(const KArgs& ka, int l, char* lds) {
  const Params p = make_params(ka);
  const int tid = otid(), wave = __builtin_amdgcn_readfirstlane(tid >> 6), lane = tid & 63, r32 = lane & 31, h = lane >> 5;
  const int wm = wave >> 1, wn = wave & 1;
  const int xcd = blockIdx.x & 7, jb = blockIdx.x >> 3, nbx = gridDim.x >> 3;
  for (int q = jb; q < 144 + 192; q += nbx) {
    if (q >= 144) {
      __syncthreads();
      const int q3 = q - 144, bh = xcd * 2 + q3 / 96, r3 = q3 % 96, pat = r3 >> 5, grp = r3 & 31;
      attn_a_block(p, bh >> 2, bh & 3, pat, grp, lds);
      continue;
    }
    const int mtl = q / 9, cc = q % 9;
    if (cc < 3) {
      const int mt = xcd * 16 + mtl, nt = cc;
      f32x16 acc[2][3];
      gemm_tile<3>(p.qlat, 256, p.WqupT + (size_t)l * 576 * 256, 256, mt * 256, nt * 192, lds, acc);
      const int head = nt * 2 + wn;
      const float* g = p.bq_g + l * 96;
#pragma unroll
      for (int a = 0; a < 2; ++a) {
        const int token = mt * 256 + wm * 64 + a * 32 + r32, b = token >> 13, sp = token & 8191;
        const float rs = rsqrtf(p.ss_ql[l * T + token] * (1.f / 256.f) + EPS);
        float v[3][16]; float ss = 0.f;
#pragma unroll
        for (int nb = 0; nb < 3; ++nb)
#pragma unroll
          for (int i = 0; i < 16; ++i) { v[nb][i] = acc[a][nb][i] * rs; ss += v[nb][i] * v[nb][i]; }
        ss = xsum32(ss);
        const float r = rsqrtf(ss * (1.f / 96.f) + EPS);
#pragma unroll
        for (int nb = 0; nb < 3; ++nb)
#pragma unroll
          for (int i = 0; i < 16; ++i) v[nb][i] *= r * g[nb * 32 + crow(i, h)];
#pragma unroll
        for (int i = 0; i < 8; ++i) {
          const float2 cs = p.rope[sp * 16 + crow(i, h)];
          const float x1 = v[2][i], x2 = v[2][i + 8];
          v[2][i] = x1 * cs.x - x2 * cs.y; v[2][i + 8] = x2 * cs.x + x1 * cs.y;
        }
        u16* d = p.Qb + ((size_t)(b * 6 + head) * S + sp) * 96;
#pragma unroll
        for (int nb = 0; nb < 3; ++nb)
#pragma unroll
          for (int g4 = 0; g4 < 4; ++g4)
            st4(d + nb * 32 + 8 * g4 + 4 * h, v[nb][4 * g4] * QSCALE96, v[nb][4 * g4 + 1] * QSCALE96, v[nb][4 * g4 + 2] * QSCALE96, v[nb][4 * g4 + 3] * QSCALE96);
      }
    } else {
      const int mt = xcd * 16 + mtl, head = cc - 3;
      f32x16 acc[2][2];
      gemm_tile<2>(p.kvlat, 128, p.WkvupT + (size_t)l * 768 * 128, 128, mt * 256, head * 128, lds, acc);
      const float* g = p.bk_g + l * 96;
#pragma unroll
      for (int a = 0; a < 2; ++a) {
        const int token = mt * 256 + wm * 64 + a * 32 + r32, b = token >> 13, sp = token & 8191;
        const float rs = rsqrtf(p.ss_kvl[l * T + token] * (1.f / 128.f) + EPS);
        if (wn == 0) {
          float ss = 0.f;
#pragma unroll
          for (int nb = 0; nb < 2; ++nb)
#pragma unroll
            for (int i = 0; i < 16; ++i) { const float t = acc[a][nb][i] * rs; ss += t * t; }
          ss = xsum32(ss) + p.kpe_ss[token];
          const float r = rsqrtf(ss * (1.f / 96.f) + EPS);
          u16* dk = p.Kb + ((size_t)(b * 6 + head) * S + sp) * 96;
          const float rr = rs * r;
#pragma unroll
          for (int nb = 0; nb < 2; ++nb)
#pragma unroll
            for (int g4 = 0; g4 < 4; ++g4) {
              const int c = nb * 32 + 8 * g4 + 4 * h;
              st4(dk + c, acc[a][nb][4 * g4] * rr * g[c], acc[a][nb][4 * g4 + 1] * rr * g[c + 1], acc[a][nb][4 * g4 + 2] * rr * g[c + 2], acc[a][nb][4 * g4 + 3] * rr * g[c + 3]);
            }
          const float* Rr = p.R + (size_t)token * 32 + 16 * h;
#pragma unroll
          for (int q = 0; q < 4; ++q) {
            const float4 t = *(const float4*)(Rr + 4 * q);
            st4(dk + 64 + 16 * h + 4 * q, t.x * r, t.y * r, t.z * r, t.w * r);
          }
        } else {
          u16* dv = p.Vb + ((size_t)(b * 6 + head) * S + sp) * 64;
#pragma unroll
          for (int nb = 0; nb < 2; ++nb)
#pragma unroll
            for (int g4 = 0; g4 < 4; ++g4) {
              const int c = nb * 32 + 8 * g4 + 4 * h;
              st4(dv + c, acc[a][nb][4 * g4] * rs, acc[a][nb][4 * g4 + 1] * rs, acc[a][nb][4 * g4 + 2] * rs, acc[a][nb][4 * g4 + 3] * rs);
            }
        }
      }
    }
  }
}

DI void phase_outproj(const KArgs& ka, int l, char* lds) {
  const Params p = make_params(ka);
  const int tid = otid(), wave = __builtin_amdgcn_readfirstlane(tid >> 6), lane = tid & 63, r32 = lane & 31, h = lane >> 5;
  const int wm = wave >> 1, wn = wave & 1;
  const u16* Wt = p.WoutT + (size_t)l * 1024 * 1024;
  const float* xin = (l == 0) ? p.x : p.out;
  char* wl = lds + wave * WREG;
  constexpr int RS = 272;
  auto epi_half = [&](const f32x16& a00, const f32x16& a01, const f32x16& a10, const f32x16& a11, int token0, int col0) {
#pragma unroll
    for (int g4 = 0; g4 < 4; ++g4) {
      *(float4*)(wl + (r32) * RS + (8 * g4 + 4 * h) * 4) = make_float4(a00[4 * g4], a00[4 * g4 + 1], a00[4 * g4 + 2], a00[4 * g4 + 3]);
      *(float4*)(wl + (r32) * RS + (32 + 8 * g4 + 4 * h) * 4) = make_float4(a01[4 * g4], a01[4 * g4 + 1], a01[4 * g4 + 2], a01[4 * g4 + 3]);
      *(float4*)(wl + (32 + r32) * RS + (8 * g4 + 4 * h) * 4) = make_float4(a10[4 * g4], a10[4 * g4 + 1], a10[4 * g4 + 2], a10[4 * g4 + 3]);
      *(float4*)(wl + (32 + r32) * RS + (32 + 8 * g4 + 4 * h) * 4) = make_float4(a11[4 * g4], a11[4 * g4 + 1], a11[4 * g4 + 2], a11[4 * g4 + 3]);
    }
    int ln = lane; asm volatile("" : "+v"(ln));
    const int ch = ln & 15;
    float4 g = make_float4(0.f, 0.f, 0.f, 0.f);
    if (l < DEPTH - 1) g = *(const float4*)(p.norm_g + (l + 1) * 1024 + col0 + ch * 4);
#pragma unroll 4
    for (int j = 0; j < 16; ++j) {
      const int row = j * 4 + (ln >> 4);
      const float4 av = *(const float4*)(wl + row * RS + ch * 16);
      const size_t go = (size_t)(token0 + row) * 1024 + col0 + ch * 4;
      float4 xo = *(const float4*)(xin + go);
      xo.x += av.x; xo.y += av.y; xo.z += av.z; xo.w += av.w;
      *(float4*)(p.out + go) = xo;
      if (l < DEPTH - 1) {
        float ss = xo.x * xo.x + xo.y * xo.y + xo.z * xo.z + xo.w * xo.w;
        st4(p.xg + go, xo.x * g.x, xo.y * g.y, xo.z * g.z, xo.w * g.w);
        ss += __shfl_xor(ss, 1, 64); ss += __shfl_xor(ss, 2, 64); ss += __shfl_xor(ss, 4, 64); ss += __shfl_xor(ss, 8, 64);
        if (ch == 0) atomicAdd(p.sumsq_x + (l + 1) * T + token0 + row, ss);
      }
    }
  };
  const int xcd = blockIdx.x & 7, jb = blockIdx.x >> 3, nbx = gridDim.x >> 3;
  const bool stag = (jb >= (nbx >> 1)) && (jb + nbx < 64) && (jb + 2 * nbx >= 64);
  for (int step = 0; step < (stag ? 3 : 1); ++step) {
    for (int q = jb; q < 64; q += nbx) {
      const int mt = xcd * 16 + (q & 15), nt = q >> 4;
      const int token0 = mt * 256 + wm * 64;
      const bool first = (q == jb);
      if (stag && ((step == 1) != !first)) continue;
      if (stag && first) {
        const int n0 = nt * 256 + (step == 2 ? 128 : 0);
        f32x16 acc[2][2];
        gemm_tile<2>(p.y, 1024, Wt, 1024, mt * 256, n0, lds, acc);
        epi_half(acc[0][0], acc[0][1], acc[1][0], acc[1][1], token0, n0 + wn * 64);
      } else {
        f32x16 acc[2][4];
        gemm_tile<4>(p.y, 1024, Wt, 1024, mt * 256, nt * 256, lds, acc);
        epi_half(acc[0][0], acc[0][1], acc[1][0], acc[1][1], token0, nt * 256 + wn * 128);
        epi_half(acc[0][2], acc[0][3], acc[1][2], acc[1][3], token0, nt * 256 + wn * 128 + 64);
      }
    }
  }
}

template <int DK>
DI void attn_dense_item(const u16* __restrict__ Qh, const u16* __restrict__ Kh, const u16* __restrict__ Vh,
                        const u16* __restrict__ gate, u16* __restrict__ yout, char* lds) {
  constexpr int KCH = DK / 8, NS = DK / 16;
  constexpr int KT = 256;
  constexpr int KBYTES = KT * DK * 2, BUF = KBYTES + KT * 128;
  constexpr int NKI = KT * KCH / 64 / NWV;
  constexpr int NVI = KT * 8 / 64 / NWV;
  const int tid = otid(), wave = __builtin_amdgcn_readfirstlane(tid >> 6), lane = tid & 63, r32 = lane & 31, h = lane >> 5;
  auto kswz = [&](int row) { return (DK == 64) ? ((row >> 1) & 7) : ((row >> 2) & 3); };
  auto koff = [&](int row, int ch) { return row * (DK * 2) + ((ch ^ kswz(row)) << 4); };
  bf16x8 qf[2][NS];
#pragma unroll
  for (int qb = 0; qb < 2; ++qb)
#pragma unroll
    for (int s = 0; s < NS; ++s) qf[qb][s] = *(const bf16x8*)(Qh + (size_t)(wave * 64 + qb * 32 + r32) * DK + s * 16 + h * 8);
  f32x16 O[2][2];
#pragma unroll
  for (int a = 0; a < 2; ++a)
#pragma unroll
    for (int b = 0; b < 2; ++b)
#pragma unroll
      for (int i = 0; i < 16; ++i) O[a][b][i] = 0.f;
  typedef __attribute__((ext_vector_type(4))) float f32x4_;
  f32x4_ L0 = {0.f, 0.f, 0.f, 0.f}, L1 = {0.f, 0.f, 0.f, 0.f};
  const short one_ = (lane == 0 || lane == 32 || lane == 17 || lane == 49) ? (short)0x3F80 : (short)0;
  const bf16x8 aones = {one_, one_, one_, one_, one_, one_, one_, one_};
  int ksrc[NKI], vsrc[NVI];
#pragma unroll
  for (int q = 0; q < NKI; ++q) { const int P = (wave * NKI + q) * 64 + lane, row = P / KCH, cp = P % KCH; ksrc[q] = row * DK + ((cp ^ kswz(row)) << 3); }
#pragma unroll
  for (int q = 0; q < NVI; ++q) { const int P = (wave * NVI + q) * 64 + lane, row = P >> 3, cp = P & 7; vsrc[q] = row * 64 + ((cp ^ (((row >> 1) & 1) << 2)) << 3); }
  auto stage = [&](int t, char* buf) {
#pragma unroll
    for (int q = 0; q < NKI; ++q)
      __builtin_amdgcn_global_load_lds((const unsigned*)(Kh + (size_t)t * KT * DK + ksrc[q]), (unsigned __attribute__((address_space(3)))*)(buf + (wave * NKI + q) * 1024), 16, 0, 0);
#pragma unroll
    for (int q = 0; q < NVI; ++q)
      __builtin_amdgcn_global_load_lds((const unsigned*)(Vh + (size_t)t * KT * 64 + vsrc[q]), (unsigned __attribute__((address_space(3)))*)(buf + KBYTES + (wave * NVI + q) * 1024), 16, 0, 0);
  };
  const int i16 = lane & 15, qq = i16 >> 2, pp = i16 & 3, blk = (lane >> 4) & 1;
  const int sw = (qq >> 1) & 1;
  int vbase[2];
  vbase[0] = KBYTES + (4 * h + qq) * 128 + ((0 ^ sw) << 6) + (16 * blk + 4 * pp) * 2;
  vbase[1] = KBYTES + (4 * h + qq) * 128 + ((1 ^ sw) << 6) + (16 * blk + 4 * pp) * 2;
  constexpr int NT = S / KT;
  stage(0, lds);
  if (wave < 4) __builtin_amdgcn_s_setprio(2); else __builtin_amdgcn_s_setprio(0);
  int cur = 0;
#pragma unroll 1
  for (int j = 0; j < NT; ++j) {
    asm volatile("s_waitcnt vmcnt(0)" ::: "memory");
    asm volatile("s_waitcnt lgkmcnt(0)" ::: "memory"); __builtin_amdgcn_s_barrier(); asm volatile("" ::: "memory");
    char* buf = lds + cur * BUF;
    if (j + 1 < NT) stage(j + 1, lds + (cur ^ 1) * BUF);
#pragma unroll
    for (int kb = 0; kb < KT / 32; ++kb) {
      f32x16 S0, S1;
#pragma unroll
      for (int i = 0; i < 16; ++i) { S0[i] = 0.f; S1[i] = 0.f; }
#pragma unroll
      for (int s = 0; s < NS; ++s) {
        const bf16x8 kf = *(const bf16x8*)(buf + koff(kb * 32 + r32, 2 * s + h));
        S0 = MFMA32(kf, qf[0][s], S0);
        S1 = MFMA32(kf, qf[1][s], S1);
      }
#pragma unroll
      for (int i = 0; i < 16; ++i) S0[i] = __builtin_amdgcn_exp2f(S0[i]);
#pragma unroll
      for (int i = 0; i < 16; ++i) S1[i] = __builtin_amdgcn_exp2f(S1[i]);
      bf16x8 pf0[2], pf1[2];
#pragma unroll
      for (int st = 0; st < 2; ++st) {
        pf0[st] = pack8(S0[8 * st], S0[8 * st + 1], S0[8 * st + 2], S0[8 * st + 3], S0[8 * st + 4], S0[8 * st + 5], S0[8 * st + 6], S0[8 * st + 7]);
        pf1[st] = pack8(S1[8 * st], S1[8 * st + 1], S1[8 * st + 2], S1[8 * st + 3], S1[8 * st + 4], S1[8 * st + 5], S1[8 * st + 6], S1[8 * st + 7]);
      }
#pragma unroll
      for (int st = 0; st < 2; ++st) {
        L0 = __builtin_amdgcn_mfma_f32_16x16x32_bf16(aones, pf0[st], L0, 0, 0, 0);
        L1 = __builtin_amdgcn_mfma_f32_16x16x32_bf16(aones, pf1[st], L1, 0, 0, 0);
      }
#pragma unroll
      for (int st = 0; st < 2; ++st)
#pragma unroll
        for (int db = 0; db < 2; ++db) {
          const char* vp = buf + vbase[db] + (kb * 32 + st * 16) * 128;
          const bf16x8 vf = cat4(trread(vp), trread(vp + 8 * 128));
          O[0][db] = MFMA32(vf, pf0[st], O[0][db]);
          O[1][db] = MFMA32(vf, pf1[st], O[1][db]);
        }
    }
#ifdef SGB
#pragma unroll
    for (int g = 0; g < 16 + 2 * NS; ++g) {
      __builtin_amdgcn_sched_group_barrier(0x008, 1, 0);
      __builtin_amdgcn_sched_group_barrier(0x002, SGB, 0);
      __builtin_amdgcn_sched_group_barrier(0x100, 1, 0);
    }
#endif
    cur ^= 1;
  }
  asm volatile("s_waitcnt lgkmcnt(0)" ::: "memory"); __builtin_amdgcn_s_barrier(); asm volatile("" ::: "memory");
  __builtin_amdgcn_s_setprio(0);
#pragma unroll
  for (int qb = 0; qb < 2; ++qb) {
    const float la_ = __shfl(qb == 0 ? L0[0] : L1[0], r32 & 15, 64), lb_ = __shfl(qb == 0 ? L0[1] : L1[1], r32 & 15, 64);
    const float inv = 1.f / (r32 < 16 ? la_ : lb_);
    const size_t ro = (size_t)(wave * 64 + qb * 32 + r32) * 1024;
#pragma unroll
    for (int db = 0; db < 2; ++db)
#pragma unroll
      for (int g4 = 0; g4 < 4; ++g4) {
        const int d = db * 32 + 8 * g4 + 4 * h;
        const uint2 gg = *(const uint2*)(gate + ro + d);
        st4(yout + ro + d, O[qb][db][4 * g4] * inv * bflo(gg.x), O[qb][db][4 * g4 + 1] * inv * bfhi(gg.x),
            O[qb][db][4 * g4 + 2] * inv * bflo(gg.y), O[qb][db][4 * g4 + 3] * inv * bfhi(gg.y));
      }
  }
}

DI void phase_attn(const KArgs& ka, char* lds) {
  const Params p = make_params(ka);
  const int wave = __builtin_amdgcn_readfirstlane(otid() >> 6);
#ifndef AMASK
#define AMASK 7
#endif
  const int xcd = blockIdx.x & 7, jb = blockIdx.x >> 3, nbx = gridDim.x >> 3;
  for (int q = jb; q < 128; q += nbx) {
    __syncthreads();
    if (q < 48) {
      if (!(AMASK & 1)) continue;
      const int qb = q & 15, bh = xcd + 8 * (q >> 4);
      const size_t ro = (size_t)bh * S;
      const int b = bh / 6, head = bh % 6;
      const size_t tok0 = (size_t)b * S + qb * 512;
      attn_dense_item<96>(p.Qb + (ro + qb * 512) * 96, p.Kb + ro * 96, p.Vb + ro * 64,
                          p.Gate + tok0 * 1024 + 256 + head * 64, p.y + tok0 * 1024 + 256 + head * 64, lds);
    } else if (q < 96) {
      if (!(AMASK & 2)) continue;
      const int q2 = q - 48, qb = q2 & 15, b = xcd >> 1, kvh = xcd & 1, head = kvh * 3 + (q2 >> 4), bh = b * 6 + head;
      const size_t tok0 = (size_t)b * S + qb * 512;
      const size_t kro = (size_t)(b * 2 + kvh) * S;
      attn_dense_item<64>(p.Qc + ((size_t)bh * S + qb * 512) * 64, p.Kc + kro * 64, p.Vc + kro * 64,
                          p.Gate + tok0 * 1024 + 640 + head * 64, p.y + tok0 * 1024 + 640 + head * 64, lds);
    } else if (q >= 112) {
      const int mt = xcd * 16 + (q - 112);
      const ALoadY al{p.y, p.PartA, p.lA, p.Gate};
      int t2 = otid();
#pragma unroll 2
      for (int c = 0; c < 16; ++c) {
        const int idx = t2 + NTH * c, row = mt * 256 + (idx >> 5), kc = (idx & 31) * 8;
        *(bf16x8*)(p.y + (size_t)row * 1024 + kc) = al(row, kc);
      }
    }
  }
}

#define XB_TMO      128
#define XB_XCNT(j)  (256  + 64 * (j))
#define XB_XSUB(j)  (1280 + 64 * (j))
#define XB_XGEN(j)  (2304 + 64 * (j))
#define XB_TOP      3328
#define XB_TOPGEN   3392
#define XCD_BAR_WORDS 3456
#define XB_SPIN_CAP (1u << 22)
DI unsigned xb_ld(unsigned* p) { return __hip_atomic_load(p, __ATOMIC_RELAXED, __HIP_MEMORY_SCOPE_AGENT); }
DI unsigned xb_add(unsigned* p, unsigned v) { return __hip_atomic_fetch_add(p, v, __ATOMIC_RELAXED, __HIP_MEMORY_SCOPE_AGENT); }
DI unsigned xb_xcc_id() { return (unsigned)__builtin_amdgcn_s_getreg((3 << 11) | 20) & 0xFu; }
#define XB_SPIN(cond, bar) do { unsigned _sp = 0; while (cond) { __builtin_amdgcn_s_sleep(1); \
    if ((++_sp & 255u) == 0u) { if (xb_ld(&(bar)[XB_TMO])) break; if (_sp > XB_SPIN_CAP) { atomicAdd(&(bar)[XB_TMO], 1u); break; } } } } while (0)
struct XcdBar { unsigned pk; };
DI XcdBar xcd_setup(unsigned* bar, char* lds) {
  XcdBar b; const unsigned bx = xb_xcc_id();
  unsigned* st = (unsigned*)lds;
  if (threadIdx.x == 0) {
    (void)xb_add(&bar[XB_XCNT(bx)], 1u);
    const unsigned G = gridDim.x;
    unsigned sum, cnt, mine, sp = 0u;
    for (;;) {
      sum = 0u; cnt = 0u; mine = 0u;
#pragma unroll
      for (unsigned j = 0; j < 16; ++j) { const unsigned c = xb_ld(&bar[XB_XCNT(j)]); sum += c; cnt += (c > 0u) ? 1u : 0u; mine = (j == bx) ? c : mine; }
      if (sum == G) break;
      __builtin_amdgcn_s_sleep(1);
      if ((++sp & 255u) == 0u) { if (xb_ld(&bar[XB_TMO])) break; if (sp > XB_SPIN_CAP) { atomicAdd(&bar[XB_TMO], 1u); break; } }
    }
    st[0] = mine > 0u ? mine : 1u; st[1] = cnt > 0u ? cnt : 1u;
  }
  __syncthreads();
  b.pk = __builtin_amdgcn_readfirstlane(bx | (st[0] << 8) | (st[1] << 20));
  __syncthreads();
  return b;
}
DI void xcd_barrier(const XcdBar& b, unsigned* bar, const unsigned epoch) {
  asm volatile("s_waitcnt vmcnt(0)" ::: "memory");
  __syncthreads();
  if (threadIdx.x == 0) {
    __builtin_amdgcn_s_waitcnt(0);
    const unsigned bx = b.pk & 15u, nloc = (b.pk >> 8) & 0xfffu, nx = b.pk >> 20;
    const unsigned old = xb_add(&bar[XB_XSUB(bx)], 1u);
    const unsigned gen = epoch;
    if (old + 1u == (gen + 1u) * nloc) {
      __builtin_amdgcn_fence(__ATOMIC_RELEASE, "agent");
      asm volatile("s_waitcnt vmcnt(0)" ::: "memory");
      const unsigned og = xb_add(&bar[XB_TOP], 1u);
      const unsigned tg = epoch;
      if (og + 1u == (tg + 1u) * nx) xb_add(&bar[XB_TOPGEN], 1u);
      else XB_SPIN(xb_ld(&bar[XB_TOPGEN]) == tg, bar);
      __builtin_amdgcn_fence(__ATOMIC_ACQUIRE, "agent");
      xb_add(&bar[XB_XGEN(bx)], 1u);
      asm volatile("s_waitcnt vmcnt(0)" ::: "memory");
    } else {
      XB_SPIN(xb_ld(&bar[XB_XGEN(bx)]) == gen, bar);
      __builtin_amdgcn_fence(__ATOMIC_ACQUIRE, "agent");
      asm volatile("s_waitcnt vmcnt(0)" ::: "memory");
    }
  }
  __syncthreads();
}

__global__ __launch_bounds__(512, 2) void mega(KArgs ka, int ph_lo, int ph_hi, int coop) {
  __shared__ __attribute__((aligned(16))) char lds[163840];
  XcdBar xb{};
  if (coop) xb = xcd_setup((unsigned*)((char*)ka.ws + OFF_bar), lds);
  for (int ph = ph_lo; ph < ph_hi; ++ph) {
#ifndef ONLY
#define ONLY -1
#endif
    if (ph == 0) { if (ONLY < 0 || ONLY == 0) phaseW(ka, lds); }
    else {
      const int l = (ph - 1) >> 2, k = (ph - 1) & 3;
      if (k == 0) { if (ONLY < 0 || ONLY == 1) phase_gemm1(ka, l, lds); }
      else if (k == 1) { if (ONLY < 0 || ONLY == 2) phase_mla_up(ka, l, lds); }
      else if (k == 2) { if (ONLY < 0 || ONLY == 3) phase_attn(ka, lds);
      }
      else { if (ONLY < 0 || ONLY == 4) phase_outproj(ka, l, lds); }
    }
    if (coop && ph + 1 < ph_hi) { if (coop == 2) cg::this_grid().sync(); else xcd_barrier(xb, (unsigned*)((char*)ka.ws + OFF_bar), (unsigned)(ph - ph_lo)); }
  }
}

extern "C" void kernel_launch(void* const* d_in, const int* in_sizes, int n_in, void* d_out, int out_size, void* d_ws, size_t ws_size,
                              hipStream_t stream) {
  KArgs p{};
  for (int i = 0; i < 14; ++i) p.in[i] = (const float AS1*)d_in[i];
  p.out = (float AS1*)d_out; p.ws = (char AS1*)d_ws;
  if (WS_TOTAL > ws_size) { fprintf(stderr, "workspace too small: need %zu have %zu\n", (size_t)WS_TOTAL, ws_size); return; }

  static int grid_blocks = 0;
  if (!grid_blocks) {
    int dev = 0, cus = 0, per_cu = 0;
    hipGetDevice(&dev);
    hipDeviceGetAttribute(&cus, hipDeviceAttributeMultiprocessorCount, dev);
    hipOccupancyMaxActiveBlocksPerMultiprocessor(&per_cu, mega, NTH, 0);
    per_cu = 1;
    grid_blocks = cus * per_cu;
  }
#if COOP
  hipMemsetAsync((char*)d_ws + OFF_bar, 0, 16384, stream);
  int lo = 0, hi = NPHASE, coop = 1;
  void* args[] = {&p, &lo, &hi, &coop};
  hipError_t e = hipLaunchCooperativeKernel((void*)mega, dim3(grid_blocks), dim3(NTH), args, 0, stream);
  if (e != hipSuccess) fprintf(stderr, "cooperative launch failed: %s (grid %d)\n", hipGetErrorString(e), grid_blocks);
#else
  for (int ph = 0; ph < NPHASE; ++ph) hipLaunchKernelGGL(mega, dim3(grid_blocks), dim3(NTH), 0, stream, p, ph, ph + 1, 0);
#endif
}
```

```cpp
#include <hip/hip_runtime.h>
#include <hip/hip_cooperative_groups.h>
#include <stdint.h>
#include <cstdio>
namespace cg = cooperative_groups;

typedef __attribute__((ext_vector_type(8))) short bf16x8;
typedef __attribute__((ext_vector_type(4))) short s16x4;
typedef __attribute__((ext_vector_type(16))) float f32x16;
typedef __attribute__((ext_vector_type(2))) float f32x2;
typedef __attribute__((ext_vector_type(2))) __bf16 bf2;
typedef __attribute__((ext_vector_type(4))) unsigned u32x4;
typedef unsigned short u16;

#define DI __device__ __forceinline__
#define MFMA32(a, b, c) __builtin_amdgcn_mfma_f32_32x32x16_bf16((a), (b), (c), 0, 0, 0)

constexpr int S = 8192, T = 32768, DEPTH = 4;
constexpr int NIN = 2848, NINP = 2944;
constexpr float EPS = 1e-6f;
constexpr int NTH = 512, NWV = 8;
constexpr float LOG2E = 1.4426950408889634f;
constexpr float QSCALE64 = 0.125f * LOG2E;
constexpr float QSCALE96 = 0.10206207261596575f * LOG2E;
#ifndef NPHASE
#define NPHASE 17
#endif
#ifndef COOP
#define COOP 1
#endif

constexpr size_t al256(size_t x) { return (x + 255) & ~(size_t)255; }
constexpr size_t OFF_WinT = 0;
constexpr size_t OFF_WoutT = OFF_WinT + al256((size_t)DEPTH * NINP * 1024 * 2);
constexpr size_t OFF_WqupT = OFF_WoutT + al256((size_t)DEPTH * 1024 * 1024 * 2);
constexpr size_t OFF_WkvupT = OFF_WqupT + al256((size_t)DEPTH * 576 * 256 * 2);
constexpr size_t OFF_xg = OFF_WkvupT + al256((size_t)DEPTH * 768 * 128 * 2);
constexpr size_t OFF_sumsq = OFF_xg + al256((size_t)T * 1024 * 2);
constexpr size_t OFF_rope = OFF_sumsq + al256((size_t)12 * T * 4);
constexpr size_t OFF_Qa = OFF_rope + al256((size_t)8192 * 16 * 8);
constexpr size_t OFF_Ka = OFF_Qa + al256((size_t)T * 256 * 2);
constexpr size_t OFF_Va = OFF_Ka + al256((size_t)T * 256 * 2);
constexpr size_t OFF_Gate = OFF_Va + al256((size_t)T * 256 * 2);
constexpr size_t OFF_qlat = OFF_Gate + al256((size_t)T * 1024 * 2);
constexpr size_t OFF_kvlat = OFF_qlat + al256((size_t)T * 256 * 2);
constexpr size_t OFF_R = OFF_kvlat + al256((size_t)T * 128 * 2);
constexpr size_t OFF_kpess = OFF_R + al256((size_t)T * 32 * 4);
constexpr size_t OFF_Qb = OFF_kpess + al256((size_t)T * 4);
constexpr size_t OFF_Kb = OFF_Qb + al256((size_t)T * 576 * 2);
constexpr size_t OFF_Vb = OFF_Kb + al256((size_t)T * 576 * 2);
constexpr size_t OFF_Qc = OFF_Vb + al256((size_t)T * 384 * 2);
constexpr size_t OFF_Kc = OFF_Qc + al256((size_t)T * 384 * 2);
constexpr size_t OFF_Vc = OFF_Kc + al256((size_t)T * 128 * 2);
constexpr size_t OFF_PartA = OFF_Vc + al256((size_t)T * 128 * 2);
constexpr size_t OFF_lA = OFF_PartA + al256((size_t)3 * T * 256 * 2);
constexpr size_t OFF_y = OFF_lA + al256((size_t)3 * T * 4 * 4);
constexpr size_t OFF_bar = OFF_y + al256((size_t)T * 1024 * 2);
constexpr size_t WS_TOTAL = OFF_bar + 16384;

#define AS1 __attribute__((address_space(1)))
struct KArgs {
  const float AS1* in[14];
  float AS1* out;
  char AS1* ws;
};
struct Params {
  const float* x; const float* norm_g; const float* w_in; const float* aq_g; const float* ak_g;
  const float* bql_g; const float* bkvl_g; const float* w_qup; const float* w_kvup;
  const float* bq_g; const float* bk_g; const float* cq_g; const float* ck_g; const float* w_out;
  float* out;
  u16* WinT; u16* WoutT; u16* WqupT; u16* WkvupT;
  u16* xg; float* sumsq_x; float* ss_ql; float* ss_kvl;
  float2* rope;
  u16* Qa; u16* Ka; u16* Va; u16* Gate; u16* qlat; u16* kvlat; float* R; float* kpe_ss;
  u16* Qb; u16* Kb; u16* Vb; u16* Qc; u16* Kc; u16* Vc; u16* PartA; float* lA; u16* y;
};
DI Params make_params(const KArgs& a) {
  Params p;
#define GP(i) ((const float*)a.in[i])
  p.x = GP(0); p.norm_g = GP(1); p.w_in = GP(2); p.aq_g = GP(3); p.ak_g = GP(4); p.bql_g = GP(5); p.bkvl_g = GP(6);
  p.w_qup = GP(7); p.w_kvup = GP(8); p.bq_g = GP(9); p.bk_g = GP(10); p.cq_g = GP(11); p.ck_g = GP(12); p.w_out = GP(13);
#undef GP
  p.out = (float*)a.out;
  char AS1* wg = a.ws; asm volatile("" : "+s"(wg));
  char* w = (char*)wg;
  p.WinT = (u16*)(w + OFF_WinT); p.WoutT = (u16*)(w + OFF_WoutT); p.WqupT = (u16*)(w + OFF_WqupT); p.WkvupT = (u16*)(w + OFF_WkvupT);
  p.xg = (u16*)(w + OFF_xg); p.sumsq_x = (float*)(w + OFF_sumsq); p.ss_ql = p.sumsq_x + 4 * T; p.ss_kvl = p.sumsq_x + 8 * T;
  p.rope = (float2*)(w + OFF_rope);
  p.Qa = (u16*)(w + OFF_Qa); p.Ka = (u16*)(w + OFF_Ka); p.Va = (u16*)(w + OFF_Va); p.Gate = (u16*)(w + OFF_Gate);
  p.qlat = (u16*)(w + OFF_qlat); p.kvlat = (u16*)(w + OFF_kvlat); p.R = (float*)(w + OFF_R); p.kpe_ss = (float*)(w + OFF_kpess);
  p.Qb = (u16*)(w + OFF_Qb); p.Kb = (u16*)(w + OFF_Kb); p.Vb = (u16*)(w + OFF_Vb);
  p.Qc = (u16*)(w + OFF_Qc); p.Kc = (u16*)(w + OFF_Kc); p.Vc = (u16*)(w + OFF_Vc);
  p.PartA = (u16*)(w + OFF_PartA); p.lA = (float*)(w + OFF_lA); p.y = (u16*)(w + OFF_y);
  return p;
}

DI unsigned pk(float a, float b) { f32x2 x = {a, b}; bf2 y = __builtin_convertvector(x, bf2); return __builtin_bit_cast(unsigned, y); }
DI float bflo(unsigned u) { return __uint_as_float(u << 16); }
DI float bfhi(unsigned u) { return __uint_as_float(u & 0xffff0000u); }
DI int otid() { int t = threadIdx.x; asm volatile("" : "+v"(t)); return t; }
DI int crow(int i, int h) { return (i & 3) + 8 * (i >> 2) + 4 * h; }
DI float xsum32(float v) { return v + __shfl_xor(v, 32, 64); }
DI void st4(u16* d, float a, float b, float c, float e) { *(uint2*)d = make_uint2(pk(a, b), pk(c, e)); }
DI bf16x8 pack8(float a0, float a1, float a2, float a3, float a4, float a5, float a6, float a7) {
  u32x4 w = {pk(a0, a1), pk(a2, a3), pk(a4, a5), pk(a6, a7)}; return __builtin_bit_cast(bf16x8, w);
}
DI int swz(int row, int ch) { return row * 128 + ((ch ^ ((row >> 1) & 7)) << 4); }
DI int voffc(int row, int ch) { return row * 128 + ((((ch >> 2) ^ (row >> 1)) & 1) << 6) + (ch & 3) * 16; }
DI s16x4 trread(const char* p) {
  return __builtin_amdgcn_ds_read_tr16_b64_v4i16((s16x4 __attribute__((address_space(3)))*)(p));
}
DI bf16x8 cat4(s16x4 lo, s16x4 hi) { return __builtin_shufflevector(lo, hi, 0, 1, 2, 3, 4, 5, 6, 7); }

DI int winmap(int n) { return n < 1408 ? n : (n < 2816 ? n + 32 : (n < 2848 ? n - 1408 : -1)); }

DI void wtrans_tile(const float* __restrict__ src, int ldsrc, u16* __restrict__ dst, int K, int k0, int n0, bool perm,
                    const float* __restrict__ rowscale, char* lds) {
  float* tile = (float*)lds;
  const int tid = otid();
  __syncthreads();
  const int c = tid & 63, r0 = tid >> 6;
  const int ncol = perm ? winmap(n0 + c) : (n0 + c);
#pragma unroll
  for (int i = 0; i < 8; ++i) {
    const int r = r0 + 8 * i;
    float v = ncol >= 0 ? src[(size_t)(k0 + r) * ldsrc + ncol] : 0.f;
    if (rowscale) v *= rowscale[k0 + r];
    tile[r * 65 + c] = v;
  }
  __syncthreads();
  {
    const int idx = tid, n = idx >> 3, ch = idx & 7;
    float e[8];
#pragma unroll
    for (int q = 0; q < 8; ++q) e[q] = tile[(ch * 8 + q) * 65 + n];
    *(bf16x8*)(dst + (size_t)(n0 + n) * K + k0 + ch * 8) = pack8(e[0], e[1], e[2], e[3], e[4], e[5], e[6], e[7]);
  }
}

DI void phaseW(const KArgs& ka, char* lds) {
  const Params p = make_params(ka);
  const int tid = otid(), nb = gridDim.x, bid = blockIdx.x;
  for (int i = bid * NTH + tid; i < 11 * T; i += nb * NTH) p.sumsq_x[T + i] = 0.f;
  for (int i = bid * NTH + tid; i < 8192 * 16; i += nb * NTH) {
    const int pos = i >> 4, j = i & 15;
    float fh = 1.f, fl = 0.f;
#pragma unroll
    for (int q = 1; q < 16; ++q) {
      constexpr double Bq[4] = {1.0, 0.5623413251903491, 0.31622776601683794, 0.1778279410038923};
      constexpr double Pq[4] = {1.0, 0.1, 0.01, 0.001};
      const double f = Bq[q & 3] * Pq[q >> 2];
      const float h_ = (float)f; const float l_ = (float)(f - (double)h_);
      if (j == q) { fh = h_; fl = l_; }
    }
    const float fp = (float)pos;
    const float a = fp * fh, e = fmaf(fp, fh, -a), alo = fmaf(fp, fl, e);
    const float k = rintf(a * 0.15915494309189535f);
    float r = fmaf(-k, 6.28125f, a);
    r = fmaf(-k, 0.0019340515136718750f, r);
    r = fmaf(-k, 1.2556659146020e-06f, r);
    r += alo;
    p.rope[i] = make_float2(cosf(r), sinf(r));
  }
  {
    const int wave = __builtin_amdgcn_readfirstlane(tid >> 6), lane = tid & 63;
    for (int row = bid * NWV + wave; row < T; row += nb * NWV) {
      const float* xr = p.x + (size_t)row * 1024;
      float ss = 0.f;
#pragma unroll
      for (int j = 0; j < 4; ++j) {
        const int c = lane * 4 + 256 * j;
        const float4 v = *(const float4*)(xr + c);
        const float4 g = *(const float4*)(p.norm_g + c);
        ss += v.x * v.x + v.y * v.y + v.z * v.z + v.w * v.w;
        st4(p.xg + (size_t)row * 1024 + c, v.x * g.x, v.y * g.y, v.z * g.z, v.w * g.w);
      }
#pragma unroll
      for (int o = 32; o >= 1; o >>= 1) ss += __shfl_xor(ss, o, 64);
      if (lane == 0) p.sumsq_x[row] = ss;
    }
  }
  constexpr int N_IN = DEPTH * 16 * 46, N_OUT = DEPTH * 16 * 16, N_QU = DEPTH * 4 * 9, N_KV = DEPTH * 2 * 12;
  for (int it = bid; it < N_IN + N_OUT + N_QU + N_KV; it += nb) {
    if (it < N_IN) {
      const int l = it / (16 * 46), r = it % (16 * 46), kt = r / 46, nt = r % 46;
      wtrans_tile(p.w_in + (size_t)l * 1024 * NIN, NIN, p.WinT + (size_t)l * NINP * 1024, 1024, kt * 64, nt * 64, true, nullptr, lds);
    } else if (it < N_IN + N_OUT) {
      const int i2 = it - N_IN, l = i2 / 256, r = i2 % 256, kt = r / 16, nt = r % 16;
      wtrans_tile(p.w_out + (size_t)l * 1024 * 1024, 1024, p.WoutT + (size_t)l * 1024 * 1024, 1024, kt * 64, nt * 64, false, nullptr, lds);
    } else if (it < N_IN + N_OUT + N_QU) {
      const int i2 = it - N_IN - N_OUT, l = i2 / 36, r = i2 % 36, kt = r / 9, nt = r % 9;
      wtrans_tile(p.w_qup + (size_t)l * 256 * 576, 576, p.WqupT + (size_t)l * 576 * 256, 256, kt * 64, nt * 64, false, p.bql_g + l * 256, lds);
    } else {
      const int i2 = it - N_IN - N_OUT - N_QU, l = i2 / 24, r = i2 % 24, kt = r / 12, nt = r % 12;
      wtrans_tile(p.w_kvup + (size_t)l * 128 * 768, 768, p.WkvupT + (size_t)l * 768 * 128, 128, kt * 64, nt * 64, false, p.bkvl_g + l * 128, lds);
    }
  }
}

struct ALoadPlain {
  const u16* A; int lda;
  DI bf16x8 operator()(int row, int kcol) const { return *(const bf16x8*)(A + (size_t)row * lda + kcol); }
};
struct ALoadY {
  const u16* y; const u16* part; const float* lA; const u16* gate;
  DI bf16x8 operator()(int row, int kcol) const {
    if (kcol >= 256) return *(const bf16x8*)(y + (size_t)row * 1024 + kcol);
    const int head = kcol >> 6;
    float o[8] = {0, 0, 0, 0, 0, 0, 0, 0}; float l = 0.f;
#pragma unroll
    for (int pt = 0; pt < 3; ++pt) {
      const uint4 u = *(const uint4*)(part + ((size_t)pt * T + row) * 256 + kcol);
      o[0] += bflo(u.x); o[1] += bfhi(u.x); o[2] += bflo(u.y); o[3] += bfhi(u.y);
      o[4] += bflo(u.z); o[5] += bfhi(u.z); o[6] += bflo(u.w); o[7] += bfhi(u.w);
      l += lA[((size_t)pt * T + row) * 4 + head];
    }
    const uint4 g = *(const uint4*)(gate + (size_t)row * 1024 + kcol);
    const float inv = 1.f / l;
    return pack8(o[0] * inv * bflo(g.x), o[1] * inv * bfhi(g.x), o[2] * inv * bflo(g.y), o[3] * inv * bfhi(g.y),
                 o[4] * inv * bflo(g.z), o[5] * inv * bfhi(g.z), o[6] * inv * bflo(g.w), o[7] * inv * bfhi(g.w));
  }
};

template <int NB>
DI void gemm_tile(const u16* __restrict__ A, int lda, const u16* __restrict__ Wt, int K, int m0, int n0, char* lds, f32x16 (&acc)[2][NB]) {
  const int tid = otid(), wave = __builtin_amdgcn_readfirstlane(tid >> 6), lane = tid & 63, r32 = lane & 31, h = lane >> 5;
  const int wm = wave >> 1, wn = wave & 1;
  constexpr int STG = 32768 + NB * 8192;
#pragma unroll
  for (int a = 0; a < 2; ++a)
#pragma unroll
    for (int b = 0; b < NB; ++b)
#pragma unroll
      for (int i = 0; i < 16; ++i) acc[a][b][i] = 0.f;
  const int nk = K >> 6;
  int asrc[4], wsrc[NB];
#pragma unroll
  for (int q = 0; q < 4; ++q) { const int P = (wave * 4 + q) * 64 + lane, row = P >> 3, cp = P & 7; asrc[q] = (m0 + row) * lda + ((cp ^ ((row >> 1) & 7)) << 3); }
#pragma unroll
  for (int q = 0; q < NB; ++q) { const int P = (wave * NB + q) * 64 + lane, row = P >> 3, cp = P & 7; wsrc[q] = (n0 + row) * K + ((cp ^ ((row >> 1) & 7)) << 3); }
  auto stage = [&](int kt, char* buf) {
#pragma unroll
    for (int q = 0; q < 4; ++q)
      __builtin_amdgcn_global_load_lds((const unsigned*)(A + (size_t)asrc[q] + kt * 64), (unsigned __attribute__((address_space(3)))*)(buf + (wave * 4 + q) * 1024), 16, 0, 0);
#pragma unroll
    for (int q = 0; q < NB; ++q)
      __builtin_amdgcn_global_load_lds((const unsigned*)(Wt + (size_t)wsrc[q] + kt * 64), (unsigned __attribute__((address_space(3)))*)(buf + 32768 + (wave * NB + q) * 1024), 16, 0, 0);
  };
  __syncthreads();
  stage(0, lds);
  asm volatile("s_waitcnt vmcnt(0)" ::: "memory");
  __syncthreads();
#pragma unroll 1
  for (int kt = 0; kt < nk; ++kt) {
    char* buf = lds + (kt & 1) * STG;
    char* nbuf = lds + ((kt + 1) & 1) * STG;
    if (kt + 1 < nk) stage(kt + 1, nbuf);
#pragma unroll
    for (int s = 0; s < 4; ++s) {
      bf16x8 af[2], wf[NB];
#pragma unroll
      for (int a = 0; a < 2; ++a) af[a] = *(const bf16x8*)(buf + swz(wm * 64 + a * 32 + r32, 2 * s + h));
#pragma unroll
      for (int b = 0; b < NB; ++b) wf[b] = *(const bf16x8*)(buf + 32768 + swz(wn * NB * 32 + b * 32 + r32, 2 * s + h));
#pragma unroll
      for (int a = 0; a < 2; ++a)
#pragma unroll
        for (int b = 0; b < NB; ++b) acc[a][b] = MFMA32(wf[b], af[a], acc[a][b]);
    }
    asm volatile("s_waitcnt vmcnt(0)" ::: "memory");
    __syncthreads();
  }
}

DI int swz64(int row, int ch) { return row * 64 + ((ch ^ ((row >> 2) & 3)) << 4); }
DI void gemm_tile4(const u16* __restrict__ A, int lda, const u16* __restrict__ Wt, int K, int m0, int n0, char* lds, f32x16 (&acc)[2][4]) {
  const int tid = otid(), wave = __builtin_amdgcn_readfirstlane(tid >> 6), lane = tid & 63, r32 = lane & 31, h = lane >> 5;
  const int wm = wave >> 1, wn = wave & 1;
  constexpr int STG = 16384 + 16384;
#pragma unroll
  for (int a = 0; a < 2; ++a)
#pragma unroll
    for (int b = 0; b < 4; ++b)
#pragma unroll
      for (int i = 0; i < 16; ++i) acc[a][b][i] = 0.f;
  const int nk = K >> 5;
  int asrc[2], wsrc[2];
#pragma unroll
  for (int q = 0; q < 2; ++q) { const int P = (wave * 2 + q) * 64 + lane, row = P >> 2, cp = P & 3; asrc[q] = (m0 + row) * lda + ((cp ^ ((row >> 2) & 3)) << 3); }
#pragma unroll
  for (int q = 0; q < 2; ++q) { const int P = (wave * 2 + q) * 64 + lane, row = P >> 2, cp = P & 3; wsrc[q] = (n0 + row) * K + ((cp ^ ((row >> 2) & 3)) << 3); }
  auto stage = [&](int kt, char* buf) {
#pragma unroll
    for (int q = 0; q < 2; ++q)
      __builtin_amdgcn_global_load_lds((const unsigned*)(A + (size_t)asrc[q] + kt * 32), (unsigned __attribute__((address_space(3)))*)(buf + (wave * 2 + q) * 1024), 16, 0, 0);
#pragma unroll
    for (int q = 0; q < 2; ++q)
      __builtin_amdgcn_global_load_lds((const unsigned*)(Wt + (size_t)wsrc[q] + kt * 32), (unsigned __attribute__((address_space(3)))*)(buf + 16384 + (wave * 2 + q) * 1024), 16, 0, 0);
  };
  __syncthreads();
  stage(0, lds); stage(1, lds + STG);
  bf16x8 af0[2], wf0[4], af1[2], wf1[4];
  auto rd = [&](const char* buf, int s, bf16x8 (&af)[2], bf16x8 (&wf)[4]) {
#pragma unroll
    for (int a = 0; a < 2; ++a) af[a] = *(const bf16x8*)(buf + swz64(wm * 64 + a * 32 + r32, 2 * s + h));
#pragma unroll
    for (int b = 0; b < 4; ++b) wf[b] = *(const bf16x8*)(buf + 16384 + swz64(wn * 128 + b * 32 + r32, 2 * s + h));
  };
  auto mm = [&](const bf16x8 (&af)[2], const bf16x8 (&wf)[4]) {
#pragma unroll
    for (int a = 0; a < 2; ++a)
#pragma unroll
      for (int b = 0; b < 4; ++b) acc[a][b] = MFMA32(wf[b], af[a], acc[a][b]);
  };
  int cur = 0;
#pragma unroll 1
  for (int kt = 0; kt < nk; ++kt) {
    if (kt + 1 < nk) asm volatile("s_waitcnt vmcnt(4)" ::: "memory"); else asm volatile("s_waitcnt vmcnt(0)" ::: "memory");
    asm volatile("s_waitcnt lgkmcnt(0)" ::: "memory"); __builtin_amdgcn_s_barrier(); asm volatile("" ::: "memory");
    const char* buf = lds + cur * STG;
    { const int nx2 = cur == 0 ? 2 : cur - 1; if (kt + 2 < nk) stage(kt + 2, lds + nx2 * STG); }
    rd(buf, 0, af0, wf0);
    if (kt > 0) mm(af1, wf1);
    rd(buf, 1, af1, wf1);
    mm(af0, wf0);
#ifndef NO_SGB4
    __builtin_amdgcn_sched_group_barrier(0x100, 6, 0);
    __builtin_amdgcn_sched_group_barrier(0x008, 8, 0);
    __builtin_amdgcn_sched_group_barrier(0x100, 6, 0);
    __builtin_amdgcn_sched_group_barrier(0x008, 8, 0);
#endif
    cur = cur == 2 ? 0 : cur + 1;
  }
  mm(af1, wf1);
  asm volatile("s_waitcnt lgkmcnt(0)" ::: "memory"); __builtin_amdgcn_s_barrier(); asm volatile("" ::: "memory");
}

constexpr int WREG = 20480;
DI void stg4(char* wl, int rs, int trow, int colbyte, float a, float b, float c, float e) {
  *(uint2*)(wl + trow * rs + colbyte) = make_uint2(pk(a, b), pk(c, e));
}
template <int CH>
DI void flush_rows(const char* wl, int rs, int lane, char* dst0, size_t dstride) {
  asm volatile("" : "+v"(lane));
#pragma unroll
  for (int j = 0; j < CH; ++j) {
    const int idx = j * 64 + lane, row = idx / CH, ch = idx % CH;
    const uint4 t = *(const uint4*)(wl + row * rs + ch * 16);
    *(uint4*)(dst0 + (size_t)row * dstride + ch * 16) = t;
  }
}
DI void epi_gemm1(const Params& p, int l, const f32x16& a0, const f32x16& a1, int token, int trow, int cb, int h, char* wl) {
  constexpr int RS = 144;
  const int sp = token & 8191;
  const float rs = rsqrtf(p.sumsq_x[l * T + token] * (1.f / 1024.f) + EPS);
  float v[2][16];
#pragma unroll
  for (int i = 0; i < 16; ++i) { v[0][i] = a0[i] * rs; v[1][i] = a1[i] * rs; }
  if (cb < 512 || (cb >= 1792 && cb < 2304)) {
    float ss = 0.f;
#pragma unroll
    for (int i = 0; i < 16; ++i) ss += v[0][i] * v[0][i] + v[1][i] * v[1][i];
    ss = xsum32(ss);
    const float r = rsqrtf(ss * (1.f / 64.f) + EPS);
    const float* g; float qs = 1.f; bool rope = false;
    if (cb < 256)       { g = p.aq_g + l * 64; qs = QSCALE64; }
    else if (cb < 512)  { g = p.ak_g + l * 64; }
    else if (cb < 2176) { g = p.cq_g + l * 64; qs = QSCALE64; rope = true; }
    else                { g = p.ck_g + l * 64; rope = true; }
    const float rq = r * qs;
#pragma unroll
    for (int nb = 0; nb < 2; ++nb)
#pragma unroll
      for (int g4 = 0; g4 < 4; ++g4) {
        const float4 gg = *(const float4*)(g + nb * 32 + 8 * g4 + 4 * h);
        v[nb][4 * g4] *= rq * gg.x; v[nb][4 * g4 + 1] *= rq * gg.y; v[nb][4 * g4 + 2] *= rq * gg.z; v[nb][4 * g4 + 3] *= rq * gg.w;
      }
    if (rope) {
#pragma unroll
      for (int nb = 0; nb < 2; ++nb) {
        const int pos = nb == 0 ? (sp >> 6) : (sp & 63);
#pragma unroll
        for (int i = 0; i < 8; ++i) {
          const float2 cs = p.rope[pos * 16 + crow(i, h)];
          const float x1 = v[nb][i], x2 = v[nb][i + 8];
          v[nb][i] = x1 * cs.x - x2 * cs.y; v[nb][i + 8] = x2 * cs.x + x1 * cs.y;
        }
      }
    }
  } else if ((cb >= 512 && cb < 768) || (cb >= 2304 && cb < 2432)) {
  } else if (cb >= 1024 && cb < 1408) {
    float ss = 0.f;
#pragma unroll
    for (int i = 0; i < 16; ++i) ss += v[0][i] * v[0][i] + v[1][i] * v[1][i];
    ss = xsum32(ss);
    if (h == 0) atomicAdd((cb < 1280 ? p.ss_ql : p.ss_kvl) + l * T + token, ss);
  } else if (cb == 2816) {
    float ss = 0.f;
#pragma unroll
    for (int i = 0; i < 16; ++i) ss += v[0][i] * v[0][i];
    ss = xsum32(ss);
    if (h == 0) p.kpe_ss[token] = ss;
    const float* g = p.bk_g + l * 96 + 64;
#pragma unroll
    for (int i = 0; i < 8; ++i) {
      const int j = crow(i, h);
      const float2 cs = p.rope[sp * 16 + j];
      const float x1 = v[0][i] * g[j], x2 = v[0][i + 8] * g[16 + j];
      v[0][i] = x1 * cs.x - x2 * cs.y; v[0][i + 8] = x2 * cs.x + x1 * cs.y;
    }
#pragma unroll
    for (int g4 = 0; g4 < 4; ++g4)
      *(float4*)(wl + trow * RS + (8 * g4 + 4 * h) * 4) = make_float4(v[0][4 * g4], v[0][4 * g4 + 1], v[0][4 * g4 + 2], v[0][4 * g4 + 3]);
    return;
  } else {
#pragma unroll
    for (int nb = 0; nb < 2; ++nb)
#pragma unroll
      for (int i = 0; i < 16; ++i) { const float x = v[nb][i]; v[nb][i] = x / (1.f + __expf(-x)); }
  }
#pragma unroll
  for (int nb = 0; nb < 2; ++nb)
#pragma unroll
    for (int g4 = 0; g4 < 4; ++g4)
      stg4(wl, RS, trow, (nb * 32 + 8 * g4 + 4 * h) * 2, v[nb][4 * g4], v[nb][4 * g4 + 1], v[nb][4 * g4 + 2], v[nb][4 * g4 + 3]);
}

DI void gemm1_flush(const Params& p, int cb, int token0, const char* wl, int lane) {
  const int b = token0 >> 13, sp0 = token0 & 8191;
  char* dst; size_t dstride;
  if (cb < 256)       { dst = (char*)(p.Qa + ((size_t)(b * 4 + (cb >> 6)) * S + sp0) * 64); dstride = 128; }
  else if (cb < 512)  { dst = (char*)(p.Ka + ((size_t)(b * 4 + ((cb - 256) >> 6)) * S + sp0) * 64); dstride = 128; }
  else if (cb < 768)  { dst = (char*)(p.Va + ((size_t)(b * 4 + ((cb - 512) >> 6)) * S + sp0) * 64); dstride = 128; }
  else if (cb < 1024) { dst = (char*)(p.Gate + (size_t)token0 * 1024 + (cb - 768)); dstride = 2048; }
  else if (cb < 1280) { dst = (char*)(p.qlat + (size_t)token0 * 256 + (cb - 1024)); dstride = 512; }
  else if (cb < 1408) { dst = (char*)(p.kvlat + (size_t)token0 * 128 + (cb - 1280)); dstride = 256; }
  else if (cb < 1792) { dst = (char*)(p.Gate + (size_t)token0 * 1024 + 256 + (cb - 1408)); dstride = 2048; }
  else if (cb < 2176) { dst = (char*)(p.Qc + ((size_t)(b * 6 + ((cb - 1792) >> 6)) * S + sp0) * 64); dstride = 128; }
  else if (cb < 2304) { dst = (char*)(p.Kc + ((size_t)(b * 2 + ((cb - 2176) >> 6)) * S + sp0) * 64); dstride = 128; }
  else if (cb < 2432) { dst = (char*)(p.Vc + ((size_t)(b * 2 + ((cb - 2304) >> 6)) * S + sp0) * 64); dstride = 128; }
  else if (cb < 2816) { dst = (char*)(p.Gate + (size_t)token0 * 1024 + 640 + (cb - 2432)); dstride = 2048; }
  else                { dst = (char*)(p.R + (size_t)token0 * 32); dstride = 128; }
  flush_rows<8>(wl, 144, lane, dst, dstride);
}

DI void phase_gemm1(const KArgs& ka, int l, char* lds) {
  const Params p = make_params(ka);
  const int tid = otid(), wave = __builtin_amdgcn_readfirstlane(tid >> 6), lane = tid & 63, r32 = lane & 31, h = lane >> 5;
  const int wm = wave >> 1, wn = wave & 1;
  const u16* Wt = p.WinT + (size_t)l * NINP * 1024;
  char* wl = lds + wave * WREG;
  const int xcd = blockIdx.x & 7, jb = blockIdx.x >> 3, nbx = gridDim.x >> 3;
  for (int q = jb; q < 192; q += nbx) {
    const int mt = xcd * 16 + (q & 15), nt = q >> 4;
    const int token0 = mt * 256 + wm * 64;
    if (nt < 11) {
      f32x16 acc[2][4];
      gemm_tile<4>(p.xg, 1024, Wt, 1024, mt * 256, nt * 256, lds, acc);
#pragma unroll
      for (int hf = 0; hf < 2; ++hf) {
        const int cb = nt * 256 + wn * 128 + hf * 64;
#pragma unroll
        for (int a = 0; a < 2; ++a) epi_gemm1(p, l, acc[a][2 * hf], acc[a][2 * hf + 1], token0 + a * 32 + r32, a * 32 + r32, cb, h, wl);
        gemm1_flush(p, cb, token0, wl, lane);
      }
    } else {
      f32x16 acc[2][2];
      gemm_tile<2>(p.xg, 1024, Wt, 1024, mt * 256, 2816, lds, acc);
      const int cb = 2816 + wn * 64;
      if (cb >= 2880) continue;
#pragma unroll
      for (int a = 0; a < 2; ++a) epi_gemm1(p, l, acc[a][0], acc[a][1], token0 + a * 32 + r32, a * 32 + r32, cb, h, wl);
      gemm1_flush(p, cb, token0, wl, lane);
    }
  }
}

DI void attn_a_block(const Params& p, int b, int head, int pat, int grp, char* lds) {
  const int tid = otid(), wave = __builtin_amdgcn_readfirstlane(tid >> 6), lane = tid & 63, r32 = lane & 31, h = lane >> 5;
  const int sh = 2 * pat, dil = 1 << sh, L = S >> sh, L32s = 8 - sh;
  const int wi0 = grp * 8, r = wi0 >> L32s, lb0 = (wi0 & ((1 << L32s) - 1)) * 32;
  const int l0 = lb0 + wave * 32, lbase = lb0 - 64;
  const size_t hb = (size_t)(b * 4 + head) * S;
  const u16* Qh = p.Qa + hb * 64; const u16* Kh = p.Ka + hb * 64; const u16* Vh = p.Va + hb * 64;
  char* Kimg = lds; char* Vimg = lds + 384 * 128;
#pragma unroll
  for (int q = 0; q < 6; ++q) {
    const int P = (wave * 6 + q) * 64 + lane, row = P >> 3, cp = P & 7;
    int lk = lbase + row; lk = lk < 0 ? 0 : (lk >= L ? L - 1 : lk);
    const size_t tok = (size_t)((lk << sh) + r) * 64;
    __builtin_amdgcn_global_load_lds((const unsigned*)(Kh + tok + ((cp ^ ((row >> 1) & 7)) << 3)), (unsigned __attribute__((address_space(3)))*)(Kimg + (wave * 6 + q) * 1024), 16, 0, 0);
    __builtin_amdgcn_global_load_lds((const unsigned*)(Vh + tok + ((cp ^ (((row >> 1) & 1) << 2)) << 3)), (unsigned __attribute__((address_space(3)))*)(Vimg + (wave * 6 + q) * 1024), 16, 0, 0);
  }
  bf16x8 qf[4];
  const int tq = ((l0 + r32) << sh) + r;
#pragma unroll
  for (int s = 0; s < 4; ++s) qf[s] = *(const bf16x8*)(Qh + (size_t)tq * 64 + 16 * s + 8 * h);
  f32x16 O0, O1;
#pragma unroll
  for (int i = 0; i < 16; ++i) { O0[i] = 0.f; O1[i] = 0.f; }
  float ls = 0.f;
  const float slope2 = exp2f(-2.f * (float)(head + 1)) * (float)dil * LOG2E;
  const float basef = (float)(4 * h - r32);
  const bool edge = (lbase < 0) || (lbase + 384 > L);
  const int i16 = lane & 15, qq = i16 >> 2, pp = i16 & 3, blk = (lane >> 4) & 1, sw = (qq >> 1) & 1;
  const int vb0 = (4 * h + qq) * 128 + ((0 ^ sw) << 6) + (16 * blk + 4 * pp) * 2;
  const int vb1 = (4 * h + qq) * 128 + ((1 ^ sw) << 6) + (16 * blk + 4 * pp) * 2;
  asm volatile("s_waitcnt vmcnt(0)" ::: "memory");
  __syncthreads();
#pragma unroll
  for (int kb = 0; kb < 5; ++kb) {
    const int rowb = wave * 32 + kb * 32;
    const int ks = l0 - 64 + 32 * kb;
    f32x16 Sx;
#pragma unroll
    for (int i = 0; i < 16; ++i) Sx[i] = 0.f;
#pragma unroll
    for (int s = 0; s < 4; ++s) {
      const bf16x8 kf = *(const bf16x8*)(Kimg + swz(rowb + r32, 2 * s + h));
      Sx = MFMA32(kf, qf[s], Sx);
    }
#pragma unroll
    for (int i = 0; i < 16; ++i) {
      const float dlf = (float)(32 * kb - 64 + (i & 3) + 8 * (i >> 2)) + basef;
      float pv = __builtin_amdgcn_exp2f(fmaf(-slope2, fabsf(dlf), Sx[i]));
      if (kb == 0 || kb == 4) pv = (fabsf(dlf) <= 64.f) ? pv : 0.f;
      Sx[i] = pv;
    }
    if (edge) {
#pragma unroll
      for (int i = 0; i < 16; ++i) { const int lkey = ks + crow(i, h); Sx[i] = (lkey >= 0 && lkey < L) ? Sx[i] : 0.f; }
    }
#pragma unroll
    for (int i = 0; i < 16; ++i) ls += Sx[i];
    bf16x8 pf[2];
#pragma unroll
    for (int st = 0; st < 2; ++st)
      pf[st] = pack8(Sx[8 * st], Sx[8 * st + 1], Sx[8 * st + 2], Sx[8 * st + 3], Sx[8 * st + 4], Sx[8 * st + 5], Sx[8 * st + 6], Sx[8 * st + 7]);
#pragma unroll
    for (int st = 0; st < 2; ++st) {
      const char* v0 = Vimg + vb0 + (rowb + st * 16) * 128;
      const char* v1 = Vimg + vb1 + (rowb + st * 16) * 128;
      const bf16x8 vf0 = cat4(trread(v0), trread(v0 + 8 * 128));
      const bf16x8 vf1 = cat4(trread(v1), trread(v1 + 8 * 128));
      O0 = MFMA32(vf0, pf[st], O0);
      O1 = MFMA32(vf1, pf[st], O1);
    }
  }
  const float lt = xsum32(ls);
  const size_t token = (size_t)b * S + tq;
  u16* d = p.PartA + ((size_t)pat * T + token) * 256 + head * 64;
#pragma unroll
  for (int g4 = 0; g4 < 4; ++g4) {
    st4(d + 8 * g4 + 4 * h, O0[4 * g4], O0[4 * g4 + 1], O0[4 * g4 + 2], O0[4 * g4 + 3]);
    st4(d + 32 + 8 * g4 + 4 * h, O1[4 * g4], O1[4 * g4 + 1], O1[4 * g4 + 2], O1[4 * g4 + 3]);
  }
  if (h == 0) p.lA[((size_t)pat * T + token) * 4 + head] = lt;
}

DI void phase_mla_up(const KArgs& ka, int l, char* lds) {
  const Params p = make_params(ka);
  const int tid = otid(), wave = __builtin_amdgcn_readfirstlane(tid >> 6), lane = tid & 63, r32 = lane & 31, h = lane >> 5;
  const int wm = wave >> 1, wn = wave & 1;
  const int xcd = blockIdx.x & 7, jb = blockIdx.x >> 3, nbx = gridDim.x >> 3;
  for (int q = jb; q < 144 + 192; q += nbx) {
    if (q >= 144) {
      __syncthreads();
      const int q3 = q - 144, bh = xcd * 2 + q3 / 96, r3 = q3 % 96, pat = r3 >> 5, grp = r3 & 31;
      attn_a_block(p, bh >> 2, bh & 3, pat, grp, lds);
      continue;
    }
    const int mtl = q / 9, cc = q % 9;
    if (cc < 3) {
      const int mt = xcd * 16 + mtl, nt = cc;
      f32x16 acc[2][3];
      gemm_tile<3>(p.qlat, 256, p.WqupT + (size_t)l * 576 * 256, 256, mt * 256, nt * 192, lds, acc);
      const int head = nt * 2 + wn;
      const float* g = p.bq_g + l * 96;
#pragma unroll
      for (int a = 0; a < 2; ++a) {
        const int token = mt * 256 + wm * 64 + a * 32 + r32, b = token >> 13, sp = token & 8191;
        const float rs = rsqrtf(p.ss_ql[l * T + token] * (1.f / 256.f) + EPS);
        float v[3][16]; float ss = 0.f;
#pragma unroll
        for (int nb = 0; nb < 3; ++nb)
#pragma unroll
          for (int i = 0; i < 16; ++i) { v[nb][i] = acc[a][nb][i] * rs; ss += v[nb][i] * v[nb][i]; }
        ss = xsum32(ss);
        const float r = rsqrtf(ss * (1.f / 96.f) + EPS);
#pragma unroll
        for (int nb = 0; nb < 3; ++nb)
#pragma unroll
          for (int i = 0; i < 16; ++i) v[nb][i] *= r * g[nb * 32 + crow(i, h)];
#pragma unroll
        for (int i = 0; i < 8; ++i) {
          const float2 cs = p.rope[sp * 16 + crow(i, h)];
          const float x1 = v[2][i], x2 = v[2][i + 8];
          v[2][i] = x1 * cs.x - x2 * cs.y; v[2][i + 8] = x2 * cs.x + x1 * cs.y;
        }
        u16* d = p.Qb + ((size_t)(b * 6 + head) * S + sp) * 96;
#pragma unroll
        for (int nb = 0; nb < 3; ++nb)
#pragma unroll
          for (int g4 = 0; g4 < 4; ++g4)
            st4(d + nb * 32 + 8 * g4 + 4 * h, v[nb][4 * g4] * QSCALE96, v[nb][4 * g4 + 1] * QSCALE96, v[nb][4 * g4 + 2] * QSCALE96, v[nb][4 * g4 + 3] * QSCALE96);
      }
    } else {
      const int mt = xcd * 16 + mtl, head = cc - 3;
      f32x16 acc[2][2];
      gemm_tile<2>(p.kvlat, 128, p.WkvupT + (size_t)l * 768 * 128, 128, mt * 256, head * 128, lds, acc);
      const float* g = p.bk_g + l * 96;
#pragma unroll
      for (int a = 0; a < 2; ++a) {
        const int token = mt * 256 + wm * 64 + a * 32 + r32, b = token >> 13, sp = token & 8191;
        const float rs = rsqrtf(p.ss_kvl[l * T + token] * (1.f / 128.f) + EPS);
        if (wn == 0) {
          float ss = 0.f;
#pragma unroll
          for (int nb = 0; nb < 2; ++nb)
#pragma unroll
            for (int i = 0; i < 16; ++i) { const float t = acc[a][nb][i] * rs; ss += t * t; }
          ss = xsum32(ss) + p.kpe_ss[token];
          const float r = rsqrtf(ss * (1.f / 96.f) + EPS);
          u16* dk = p.Kb + ((size_t)(b * 6 + head) * S + sp) * 96;
          const float rr = rs * r;
#pragma unroll
          for (int nb = 0; nb < 2; ++nb)
#pragma unroll
            for (int g4 = 0; g4 < 4; ++g4) {
              const int c = nb * 32 + 8 * g4 + 4 * h;
              st4(dk + c, acc[a][nb][4 * g4] * rr * g[c], acc[a][nb][4 * g4 + 1] * rr * g[c + 1], acc[a][nb][4 * g4 + 2] * rr * g[c + 2], acc[a][nb][4 * g4 + 3] * rr * g[c + 3]);
            }
          const float* Rr = p.R + (size_t)token * 32 + 16 * h;
#pragma unroll
          for (int q = 0; q < 4; ++q) {
            const float4 t = *(const float4*)(Rr + 4 * q);
            st4(dk + 64 + 16 * h + 4 * q, t.x * r, t.y * r, t.z * r, t.w * r);
          }
        } else {
          u16* dv = p.Vb + ((size_t)(b * 6 + head) * S + sp) * 64;
#pragma unroll
          for (int nb = 0; nb < 2; ++nb)
#pragma unroll
            for (int g4 = 0; g4 < 4; ++g4) {
              const int c = nb * 32 + 8 * g4 + 4 * h;
              st4(dv + c, acc[a][nb][4 * g4] * rs, acc[a][nb][4 * g4 + 1] * rs, acc[a][nb][4 * g4 + 2] * rs, acc[a][nb][4 * g4 + 3] * rs);
            }
        }
      }
    }
  }
}

DI void phase_outproj(const KArgs& ka, int l, char* lds) {
  const Params p = make_params(ka);
  const int tid = otid(), wave = __builtin_amdgcn_readfirstlane(tid >> 6), lane = tid & 63, r32 = lane & 31, h = lane >> 5;
  const int wm = wave >> 1, wn = wave & 1;
  const u16* Wt = p.WoutT + (size_t)l * 1024 * 1024;
  const float* xin = (l == 0) ? p.x : p.out;
  char* wl = lds + wave * WREG;
  constexpr int RS = 272;
  const int xcd = blockIdx.x & 7, jb = blockIdx.x >> 3, nbx = gridDim.x >> 3;
  for (int q = jb; q < 64; q += nbx) {
    const int mt = xcd * 16 + (q & 15), nt = q >> 4;
    f32x16 acc[2][4];
    gemm_tile<4>(p.y, 1024, Wt, 1024, mt * 256, nt * 256, lds, acc);
    const int token0 = mt * 256 + wm * 64;
#pragma unroll
    for (int hf = 0; hf < 2; ++hf) {
      const int col0 = nt * 256 + wn * 128 + hf * 64;
#pragma unroll
      for (int a = 0; a < 2; ++a)
#pragma unroll
        for (int nb = 0; nb < 2; ++nb)
#pragma unroll
          for (int g4 = 0; g4 < 4; ++g4)
            *(float4*)(wl + (a * 32 + r32) * RS + (nb * 32 + 8 * g4 + 4 * h) * 4) =
                make_float4(acc[a][2 * hf + nb][4 * g4], acc[a][2 * hf + nb][4 * g4 + 1], acc[a][2 * hf + nb][4 * g4 + 2], acc[a][2 * hf + nb][4 * g4 + 3]);
      int ln = lane; asm volatile("" : "+v"(ln));
      const int ch = ln & 15;
      float4 g = make_float4(0.f, 0.f, 0.f, 0.f);
      if (l < DEPTH - 1) g = *(const float4*)(p.norm_g + (l + 1) * 1024 + col0 + ch * 4);
#pragma unroll 4
      for (int j = 0; j < 16; ++j) {
        const int row = j * 4 + (ln >> 4);
        const float4 av = *(const float4*)(wl + row * RS + ch * 16);
        const size_t go = (size_t)(token0 + row) * 1024 + col0 + ch * 4;
        float4 xo = *(const float4*)(xin + go);
        xo.x += av.x; xo.y += av.y; xo.z += av.z; xo.w += av.w;
        *(float4*)(p.out + go) = xo;
        if (l < DEPTH - 1) {
          float ss = xo.x * xo.x + xo.y * xo.y + xo.z * xo.z + xo.w * xo.w;
          st4(p.xg + go, xo.x * g.x, xo.y * g.y, xo.z * g.z, xo.w * g.w);
          ss += __shfl_xor(ss, 1, 64); ss += __shfl_xor(ss, 2, 64); ss += __shfl_xor(ss, 4, 64); ss += __shfl_xor(ss, 8, 64);
          if (ch == 0) atomicAdd(p.sumsq_x + (l + 1) * T + token0 + row, ss);
        }
      }
    }
  }
}

template <int DK>
DI void attn_dense_item(const u16* __restrict__ Qh, const u16* __restrict__ Kh, const u16* __restrict__ Vh,
                        const u16* __restrict__ gate, u16* __restrict__ yout, char* lds) {
  constexpr int KCH = DK / 8, NS = DK / 16;
  constexpr int KT = 256;
  constexpr int KBYTES = KT * DK * 2, BUF = KBYTES + KT * 128;
  constexpr int NKI = KT * KCH / 64 / NWV;
  constexpr int NVI = KT * 8 / 64 / NWV;
  const int tid = otid(), wave = __builtin_amdgcn_readfirstlane(tid >> 6), lane = tid & 63, r32 = lane & 31, h = lane >> 5;
  auto kswz = [&](int row) { return (DK == 64) ? ((row >> 1) & 7) : ((row >> 2) & 3); };
  auto koff = [&](int row, int ch) { return row * (DK * 2) + ((ch ^ kswz(row)) << 4); };
  bf16x8 qf[2][NS];
#pragma unroll
  for (int qb = 0; qb < 2; ++qb)
#pragma unroll
    for (int s = 0; s < NS; ++s) qf[qb][s] = *(const bf16x8*)(Qh + (size_t)(wave * 64 + qb * 32 + r32) * DK + s * 16 + h * 8);
  f32x16 O[2][2];
#pragma unroll
  for (int a = 0; a < 2; ++a)
#pragma unroll
    for (int b = 0; b < 2; ++b)
#pragma unroll
      for (int i = 0; i < 16; ++i) O[a][b][i] = 0.f;
  typedef __attribute__((ext_vector_type(4))) float f32x4_;
  f32x4_ L0 = {0.f, 0.f, 0.f, 0.f}, L1 = {0.f, 0.f, 0.f, 0.f};
  const short one_ = (lane == 0 || lane == 32 || lane == 17 || lane == 49) ? (short)0x3F80 : (short)0;
  const bf16x8 aones = {one_, one_, one_, one_, one_, one_, one_, one_};
  int ksrc[NKI], vsrc[NVI];
#pragma unroll
  for (int q = 0; q < NKI; ++q) { const int P = (wave * NKI + q) * 64 + lane, row = P / KCH, cp = P % KCH; ksrc[q] = row * DK + ((cp ^ kswz(row)) << 3); }
#pragma unroll
  for (int q = 0; q < NVI; ++q) { const int P = (wave * NVI + q) * 64 + lane, row = P >> 3, cp = P & 7; vsrc[q] = row * 64 + ((cp ^ (((row >> 1) & 1) << 2)) << 3); }
  auto stage = [&](int t, char* buf) {
#pragma unroll
    for (int q = 0; q < NKI; ++q)
      __builtin_amdgcn_global_load_lds((const unsigned*)(Kh + (size_t)t * KT * DK + ksrc[q]), (unsigned __attribute__((address_space(3)))*)(buf + (wave * NKI + q) * 1024), 16, 0, 0);
#pragma unroll
    for (int q = 0; q < NVI; ++q)
      __builtin_amdgcn_global_load_lds((const unsigned*)(Vh + (size_t)t * KT * 64 + vsrc[q]), (unsigned __attribute__((address_space(3)))*)(buf + KBYTES + (wave * NVI + q) * 1024), 16, 0, 0);
  };
  const int i16 = lane & 15, qq = i16 >> 2, pp = i16 & 3, blk = (lane >> 4) & 1;
  const int sw = (qq >> 1) & 1;
  int vbase[2];
  vbase[0] = KBYTES + (4 * h + qq) * 128 + ((0 ^ sw) << 6) + (16 * blk + 4 * pp) * 2;
  vbase[1] = KBYTES + (4 * h + qq) * 128 + ((1 ^ sw) << 6) + (16 * blk + 4 * pp) * 2;
  constexpr int NT = S / KT;
  stage(0, lds);
  if (wave < 4) __builtin_amdgcn_s_setprio(2); else __builtin_amdgcn_s_setprio(0);
  int cur = 0;
#pragma unroll 1
  for (int j = 0; j < NT; ++j) {
    asm volatile("s_waitcnt vmcnt(0)" ::: "memory");
    asm volatile("s_waitcnt lgkmcnt(0)" ::: "memory"); __builtin_amdgcn_s_barrier(); asm volatile("" ::: "memory");
    char* buf = lds + cur * BUF;
    if (j + 1 < NT) stage(j + 1, lds + (cur ^ 1) * BUF);
#pragma unroll
    for (int kb = 0; kb < KT / 32; ++kb) {
      f32x16 S0, S1;
#pragma unroll
      for (int i = 0; i < 16; ++i) { S0[i] = 0.f; S1[i] = 0.f; }
#pragma unroll
      for (int s = 0; s < NS; ++s) {
        const bf16x8 kf = *(const bf16x8*)(buf + koff(kb * 32 + r32, 2 * s + h));
        S0 = MFMA32(kf, qf[0][s], S0);
        S1 = MFMA32(kf, qf[1][s], S1);
      }
#pragma unroll
      for (int i = 0; i < 16; ++i) S0[i] = __builtin_amdgcn_exp2f(S0[i]);
#pragma unroll
      for (int i = 0; i < 16; ++i) S1[i] = __builtin_amdgcn_exp2f(S1[i]);
      bf16x8 pf0[2], pf1[2];
#pragma unroll
      for (int st = 0; st < 2; ++st) {
        pf0[st] = pack8(S0[8 * st], S0[8 * st + 1], S0[8 * st + 2], S0[8 * st + 3], S0[8 * st + 4], S0[8 * st + 5], S0[8 * st + 6], S0[8 * st + 7]);
        pf1[st] = pack8(S1[8 * st], S1[8 * st + 1], S1[8 * st + 2], S1[8 * st + 3], S1[8 * st + 4], S1[8 * st + 5], S1[8 * st + 6], S1[8 * st + 7]);
      }
#pragma unroll
      for (int st = 0; st < 2; ++st) {
        L0 = __builtin_amdgcn_mfma_f32_16x16x32_bf16(aones, pf0[st], L0, 0, 0, 0);
        L1 = __builtin_amdgcn_mfma_f32_16x16x32_bf16(aones, pf1[st], L1, 0, 0, 0);
      }
#pragma unroll
      for (int st = 0; st < 2; ++st)
#pragma unroll
        for (int db = 0; db < 2; ++db) {
          const char* vp = buf + vbase[db] + (kb * 32 + st * 16) * 128;
          const bf16x8 vf = cat4(trread(vp), trread(vp + 8 * 128));
          O[0][db] = MFMA32(vf, pf0[st], O[0][db]);
          O[1][db] = MFMA32(vf, pf1[st], O[1][db]);
        }
    }
#ifdef SGB
#pragma unroll
    for (int g = 0; g < 16 + 2 * NS; ++g) {
      __builtin_amdgcn_sched_group_barrier(0x008, 1, 0);
      __builtin_amdgcn_sched_group_barrier(0x002, SGB, 0);
      __builtin_amdgcn_sched_group_barrier(0x100, 1, 0);
    }
#endif
    cur ^= 1;
  }
  asm volatile("s_waitcnt lgkmcnt(0)" ::: "memory"); __builtin_amdgcn_s_barrier(); asm volatile("" ::: "memory");
  __builtin_amdgcn_s_setprio(0);
#pragma unroll
  for (int qb = 0; qb < 2; ++qb) {
    const float la_ = __shfl(qb == 0 ? L0[0] : L1[0], r32 & 15, 64), lb_ = __shfl(qb == 0 ? L0[1] : L1[1], r32 & 15, 64);
    const float inv = 1.f / (r32 < 16 ? la_ : lb_);
    const size_t ro = (size_t)(wave * 64 + qb * 32 + r32) * 1024;
#pragma unroll
    for (int db = 0; db < 2; ++db)
#pragma unroll
      for (int g4 = 0; g4 < 4; ++g4) {
        const int d = db * 32 + 8 * g4 + 4 * h;
        const uint2 gg = *(const uint2*)(gate + ro + d);
        st4(yout + ro + d, O[qb][db][4 * g4] * inv * bflo(gg.x), O[qb][db][4 * g4 + 1] * inv * bfhi(gg.x),
            O[qb][db][4 * g4 + 2] * inv * bflo(gg.y), O[qb][db][4 * g4 + 3] * inv * bfhi(gg.y));
      }
  }
}

DI void phase_attn(const KArgs& ka, char* lds) {
  const Params p = make_params(ka);
  const int wave = __builtin_amdgcn_readfirstlane(otid() >> 6);
#ifndef AMASK
#define AMASK 7
#endif
  const int xcd = blockIdx.x & 7, jb = blockIdx.x >> 3, nbx = gridDim.x >> 3;
  for (int q = jb; q < 128; q += nbx) {
    __syncthreads();
    if (q < 48) {
      if (!(AMASK & 1)) continue;
      const int qb = q & 15, bh = xcd + 8 * (q >> 4);
      const size_t ro = (size_t)bh * S;
      const int b = bh / 6, head = bh % 6;
      const size_t tok0 = (size_t)b * S + qb * 512;
      attn_dense_item<96>(p.Qb + (ro + qb * 512) * 96, p.Kb + ro * 96, p.Vb + ro * 64,
                          p.Gate + tok0 * 1024 + 256 + head * 64, p.y + tok0 * 1024 + 256 + head * 64, lds);
    } else if (q < 96) {
      if (!(AMASK & 2)) continue;
      const int q2 = q - 48, qb = q2 & 15, b = xcd >> 1, kvh = xcd & 1, head = kvh * 3 + (q2 >> 4), bh = b * 6 + head;
      const size_t tok0 = (size_t)b * S + qb * 512;
      const size_t kro = (size_t)(b * 2 + kvh) * S;
      attn_dense_item<64>(p.Qc + ((size_t)bh * S + qb * 512) * 64, p.Kc + kro * 64, p.Vc + kro * 64,
                          p.Gate + tok0 * 1024 + 640 + head * 64, p.y + tok0 * 1024 + 640 + head * 64, lds);
    } else if (q >= 112) {
      const int mt = xcd * 16 + (q - 112);
      const ALoadY al{p.y, p.PartA, p.lA, p.Gate};
      int t2 = otid();
#pragma unroll 2
      for (int c = 0; c < 16; ++c) {
        const int idx = t2 + NTH * c, row = mt * 256 + (idx >> 5), kc = (idx & 31) * 8;
        *(bf16x8*)(p.y + (size_t)row * 1024 + kc) = al(row, kc);
      }
    }
  }
}

#define XB_TMO      128
#define XB_XCNT(j)  (256  + 64 * (j))
#define XB_XSUB(j)  (1280 + 64 * (j))
#define XB_XGEN(j)  (2304 + 64 * (j))
#define XB_TOP      3328
#define XB_TOPGEN   3392
#define XCD_BAR_WORDS 3456
#define XB_SPIN_CAP (1u << 22)
DI unsigned xb_ld(unsigned* p) { return __hip_atomic_load(p, __ATOMIC_RELAXED, __HIP_MEMORY_SCOPE_AGENT); }
DI unsigned xb_add(unsigned* p, unsigned v) { return __hip_atomic_fetch_add(p, v, __ATOMIC_RELAXED, __HIP_MEMORY_SCOPE_AGENT); }
DI unsigned xb_xcc_id() { return (unsigned)__builtin_amdgcn_s_getreg((3 << 11) | 20) & 0xFu; }
#define XB_SPIN(cond, bar) do { unsigned _sp = 0; while (cond) { __builtin_amdgcn_s_sleep(1); \
    if ((++_sp & 255u) == 0u) { if (xb_ld(&(bar)[XB_TMO])) break; if (_sp > XB_SPIN_CAP) { atomicAdd(&(bar)[XB_TMO], 1u); break; } } } } while (0)
struct XcdBar { unsigned pk; };
DI XcdBar xcd_setup(unsigned* bar, char* lds) {
  XcdBar b; const unsigned bx = xb_xcc_id();
  unsigned* st = (unsigned*)lds;
  if (threadIdx.x == 0) {
    (void)xb_add(&bar[XB_XCNT(bx)], 1u);
    const unsigned G = gridDim.x;
    unsigned sum, cnt, mine, sp = 0u;
    for (;;) {
      sum = 0u; cnt = 0u; mine = 0u;
#pragma unroll
      for (unsigned j = 0; j < 16; ++j) { const unsigned c = xb_ld(&bar[XB_XCNT(j)]); sum += c; cnt += (c > 0u) ? 1u : 0u; mine = (j == bx) ? c : mine; }
      if (sum == G) break;
      __builtin_amdgcn_s_sleep(1);
      if ((++sp & 255u) == 0u) { if (xb_ld(&bar[XB_TMO])) break; if (sp > XB_SPIN_CAP) { atomicAdd(&bar[XB_TMO], 1u); break; } }
    }
    st[0] = mine > 0u ? mine : 1u; st[1] = cnt > 0u ? cnt : 1u;
  }
  __syncthreads();
  b.pk = __builtin_amdgcn_readfirstlane(bx | (st[0] << 8) | (st[1] << 20));
  __syncthreads();
  return b;
}
DI void xcd_barrier(const XcdBar& b, unsigned* bar, const unsigned epoch) {
  asm volatile("s_waitcnt vmcnt(0)" ::: "memory");
  __syncthreads();
  if (threadIdx.x == 0) {
    __builtin_amdgcn_s_waitcnt(0);
    const unsigned bx = b.pk & 15u, nloc = (b.pk >> 8) & 0xfffu, nx = b.pk >> 20;
    const unsigned old = xb_add(&bar[XB_XSUB(bx)], 1u);
    const unsigned gen = epoch;
    if (old + 1u == (gen + 1u) * nloc) {
      __builtin_amdgcn_fence(__ATOMIC_RELEASE, "agent");
      asm volatile("s_waitcnt vmcnt(0)" ::: "memory");
      const unsigned og = xb_add(&bar[XB_TOP], 1u);
      const unsigned tg = epoch;
      if (og + 1u == (tg + 1u) * nx) xb_add(&bar[XB_TOPGEN], 1u);
      else XB_SPIN(xb_ld(&bar[XB_TOPGEN]) == tg, bar);
      __builtin_amdgcn_fence(__ATOMIC_ACQUIRE, "agent");
      xb_add(&bar[XB_XGEN(bx)], 1u);
      asm volatile("s_waitcnt vmcnt(0)" ::: "memory");
    } else {
      XB_SPIN(xb_ld(&bar[XB_XGEN(bx)]) == gen, bar);
      __builtin_amdgcn_fence(__ATOMIC_ACQUIRE, "agent");
      asm volatile("s_waitcnt vmcnt(0)" ::: "memory");
    }
  }
  __syncthreads();
}

__global__ __launch_bounds__(512, 2) void mega(KArgs ka, int ph_lo, int ph_hi, int coop) {
  __shared__ __attribute__((aligned(16))) char lds[163840];
  XcdBar xb{};
  if (coop) xb = xcd_setup((unsigned*)((char*)ka.ws + OFF_bar), lds);
  for (int ph = ph_lo; ph < ph_hi; ++ph) {
#ifndef ONLY
#define ONLY -1
#endif
    if (ph == 0) { if (ONLY < 0 || ONLY == 0) phaseW(ka, lds); }
    else {
      const int l = (ph - 1) >> 2, k = (ph - 1) & 3;
      if (k == 0) { if (ONLY < 0 || ONLY == 1) phase_gemm1(ka, l, lds); }
      else if (k == 1) { if (ONLY < 0 || ONLY == 2) phase_mla_up(ka, l, lds); }
      else if (k == 2) { if (ONLY < 0 || ONLY == 3) phase_attn(ka, lds);
      }
      else { if (ONLY < 0 || ONLY == 4) phase_outproj(ka, l, lds); }
    }
    if (coop && ph + 1 < ph_hi) { if (coop == 2) cg::this_grid().sync(); else xcd_barrier(xb, (unsigned*)((char*)ka.ws + OFF_bar), (unsigned)(ph - ph_lo)); }
  }
}

extern "C" void kernel_launch(void* const* d_in, const int* in_sizes, int n_in, void* d_out, int out_size, void* d_ws, size_t ws_size,
                              hipStream_t stream) {
  KArgs p{};
  for (int i = 0; i < 14; ++i) p.in[i] = (const float AS1*)d_in[i];
  p.out = (float AS1*)d_out; p.ws = (char AS1*)d_ws;
  if (WS_TOTAL > ws_size) { fprintf(stderr, "workspace too small: need %zu have %zu\n", (size_t)WS_TOTAL, ws_size); return; }

  static int grid_blocks = 0;
  if (!grid_blocks) {
    int dev = 0, cus = 0, per_cu = 0;
    hipGetDevice(&dev);
    hipDeviceGetAttribute(&cus, hipDeviceAttributeMultiprocessorCount, dev);
    hipOccupancyMaxActiveBlocksPerMultiprocessor(&per_cu, mega, NTH, 0);
    per_cu = 1;
    grid_blocks = cus * per_cu;
  }
#if COOP
  hipMemsetAsync((char*)d_ws + OFF_bar, 0, 16384, stream);
  int lo = 0, hi = NPHASE, coop = 1;
  void* args[] = {&p, &lo, &hi, &coop};
  hipError_t e = hipLaunchCooperativeKernel((void*)mega, dim3(grid_blocks), dim3(NTH), args, 0, stream);
  if (e != hipSuccess) fprintf(stderr, "cooperative launch failed: %s (grid %d)\n", hipGetErrorString(e), grid_blocks);
#else
  for (int ph = 0; ph < NPHASE; ++ph) hipLaunchKernelGGL(mega, dim3(grid_blocks), dim3(NTH), 0, stream, p, ph, ph + 1, 0);
#endif
}
```

```cpp
#include <hip/hip_runtime.h>
#include <hip/hip_cooperative_groups.h>
#include <stdint.h>
#include <cstdio>
namespace cg = cooperative_groups;

typedef __attribute__((ext_vector_type(8))) short bf16x8;
typedef __attribute__((ext_vector_type(4))) short s16x4;
typedef __attribute__((ext_vector_type(16))) float f32x16;
typedef __attribute__((ext_vector_type(2))) float f32x2;
typedef __attribute__((ext_vector_type(2))) __bf16 bf2;
typedef __attribute__((ext_vector_type(4))) unsigned u32x4;
typedef unsigned short u16;

#define DI __device__ __forceinline__
#define MFMA32(a, b, c) __builtin_amdgcn_mfma_f32_32x32x16_bf16((a), (b), (c), 0, 0, 0)

constexpr int S = 8192, T = 32768, DEPTH = 4;
constexpr int NIN = 2848, NINP = 2944;
constexpr float EPS = 1e-6f;
constexpr int NTH = 512, NWV = 8;
constexpr float LOG2E = 1.4426950408889634f;
constexpr float QSCALE64 = 0.125f * LOG2E;
constexpr float QSCALE96 = 0.10206207261596575f * LOG2E;
#ifndef NPHASE
#define NPHASE 17
#endif
#ifndef COOP
#define COOP 1
#endif

constexpr size_t al256(size_t x) { return (x + 255) & ~(size_t)255; }
constexpr size_t OFF_WinT = 0;
constexpr size_t OFF_WoutT = OFF_WinT + al256((size_t)DEPTH * NINP * 1024 * 2);
constexpr size_t OFF_WqupT = OFF_WoutT + al256((size_t)DEPTH * 1024 * 1024 * 2);
constexpr size_t OFF_WkvupT = OFF_WqupT + al256((size_t)DEPTH * 576 * 256 * 2);
constexpr size_t OFF_xg = OFF_WkvupT + al256((size_t)DEPTH * 768 * 128 * 2);
constexpr size_t OFF_sumsq = OFF_xg + al256((size_t)T * 1024 * 2);
constexpr size_t OFF_rope = OFF_sumsq + al256((size_t)12 * T * 4);
constexpr size_t OFF_Qa = OFF_rope + al256((size_t)8192 * 16 * 8);
constexpr size_t OFF_Ka = OFF_Qa + al256((size_t)T * 256 * 2);
constexpr size_t OFF_Va = OFF_Ka + al256((size_t)T * 256 * 2);
constexpr size_t OFF_Gate = OFF_Va + al256((size_t)T * 256 * 2);
constexpr size_t OFF_qlat = OFF_Gate + al256((size_t)T * 1024 * 2);
constexpr size_t OFF_kvlat = OFF_qlat + al256((size_t)T * 256 * 2);
constexpr size_t OFF_R = OFF_kvlat + al256((size_t)T * 128 * 2);
constexpr size_t OFF_kpess = OFF_R + al256((size_t)T * 32 * 4);
constexpr size_t OFF_Qb = OFF_kpess + al256((size_t)T * 4);
constexpr size_t OFF_Kb = OFF_Qb + al256((size_t)T * 576 * 2);
constexpr size_t OFF_Vb = OFF_Kb + al256((size_t)T * 576 * 2);
constexpr size_t OFF_Qc = OFF_Vb + al256((size_t)T * 384 * 2);
constexpr size_t OFF_Kc = OFF_Qc + al256((size_t)T * 384 * 2);
constexpr size_t OFF_Vc = OFF_Kc + al256((size_t)T * 128 * 2);
constexpr size_t OFF_PartA = OFF_Vc + al256((size_t)T * 128 * 2);
constexpr size_t OFF_lA = OFF_PartA + al256((size_t)3 * T * 256 * 2);
constexpr size_t OFF_y = OFF_lA + al256((size_t)3 * T * 4 * 4);
constexpr size_t OFF_bar = OFF_y + al256((size_t)T * 1024 * 2);
constexpr size_t WS_TOTAL = OFF_bar + 16384;

#define AS1 __attribute__((address_space(1)))
struct KArgs {
  const float AS1* in[14];
  float AS1* out;
  char AS1* ws;
};
struct Params {
  const float* x; const float* norm_g; const float* w_in; const float* aq_g; const float* ak_g;
  const float* bql_g; const float* bkvl_g; const float* w_qup; const float* w_kvup;
  const float* bq_g; const float* bk_g; const float* cq_g; const float* ck_g; const float* w_out;
  float* out;
  u16* WinT; u16* WoutT; u16* WqupT; u16* WkvupT;
  u16* xg; float* sumsq_x; float* ss_ql; float* ss_kvl;
  float2* rope;
  u16* Qa; u16* Ka; u16* Va; u16* Gate; u16* qlat; u16* kvlat; float* R; float* kpe_ss;
  u16* Qb; u16* Kb; u16* Vb; u16* Qc; u16* Kc; u16* Vc; u16* PartA; float* lA; u16* y;
};
DI Params make_params(const KArgs& a) {
  Params p;
#define GP(i) ((const float*)a.in[i])
  p.x = GP(0); p.norm_g = GP(1); p.w_in = GP(2); p.aq_g = GP(3); p.ak_g = GP(4); p.bql_g = GP(5); p.bkvl_g = GP(6);
  p.w_qup = GP(7); p.w_kvup = GP(8); p.bq_g = GP(9); p.bk_g = GP(10); p.cq_g = GP(11); p.ck_g = GP(12); p.w_out = GP(13);
#undef GP
  p.out = (float*)a.out;
  char AS1* wg = a.ws; asm volatile("" : "+s"(wg));
  char* w = (char*)wg;
  p.WinT = (u16*)(w + OFF_WinT); p.WoutT = (u16*)(w + OFF_WoutT); p.WqupT = (u16*)(w + OFF_WqupT); p.WkvupT = (u16*)(w + OFF_WkvupT);
  p.xg = (u16*)(w + OFF_xg); p.sumsq_x = (float*)(w + OFF_sumsq); p.ss_ql = p.sumsq_x + 4 * T; p.ss_kvl = p.sumsq_x + 8 * T;
  p.rope = (float2*)(w + OFF_rope);
  p.Qa = (u16*)(w + OFF_Qa); p.Ka = (u16*)(w + OFF_Ka); p.Va = (u16*)(w + OFF_Va); p.Gate = (u16*)(w + OFF_Gate);
  p.qlat = (u16*)(w + OFF_qlat); p.kvlat = (u16*)(w + OFF_kvlat); p.R = (float*)(w + OFF_R); p.kpe_ss = (float*)(w + OFF_kpess);
  p.Qb = (u16*)(w + OFF_Qb); p.Kb = (u16*)(w + OFF_Kb); p.Vb = (u16*)(w + OFF_Vb);
  p.Qc = (u16*)(w + OFF_Qc); p.Kc = (u16*)(w + OFF_Kc); p.Vc = (u16*)(w + OFF_Vc);
  p.PartA = (u16*)(w + OFF_PartA); p.lA = (float*)(w + OFF_lA); p.y = (u16*)(w + OFF_y);
  return p;
}

DI unsigned pk(float a, float b) { f32x2 x = {a, b}; bf2 y = __builtin_convertvector(x, bf2); return __builtin_bit_cast(unsigned, y); }
DI float bflo(unsigned u) { return __uint_as_float(u << 16); }
DI float bfhi(unsigned u) { return __uint_as_float(u & 0xffff0000u); }
DI int otid() { int t = threadIdx.x; asm volatile("" : "+v"(t)); return t; }
DI int crow(int i, int h) { return (i & 3) + 8 * (i >> 2) + 4 * h; }
DI float xsum32(float v) { return v + __shfl_xor(v, 32, 64); }
DI void st4(u16* d, float a, float b, float c, float e) { *(uint2*)d = make_uint2(pk(a, b), pk(c, e)); }
DI bf16x8 pack8(float a0, float a1, float a2, float a3, float a4, float a5, float a6, float a7) {
  u32x4 w = {pk(a0, a1), pk(a2, a3), pk(a4, a5), pk(a6, a7)}; return __builtin_bit_cast(bf16x8, w);
}
DI int swz(int row, int ch) { return row * 128 + ((ch ^ ((row >> 1) & 7)) << 4); }
DI int voffc(int row, int ch) { return row * 128 + ((((ch >> 2) ^ (row >> 1)) & 1) << 6) + (ch & 3) * 16; }
DI s16x4 trread(const char* p) {
  return __builtin_amdgcn_ds_read_tr16_b64_v4i16((s16x4 __attribute__((address_space(3)))*)(p));
}
DI bf16x8 cat4(s16x4 lo, s16x4 hi) { return __builtin_shufflevector(lo, hi, 0, 1, 2, 3, 4, 5, 6, 7); }

DI int winmap(int n) { return n < 1408 ? n : (n < 2816 ? n + 32 : (n < 2848 ? n - 1408 : -1)); }

DI void wtrans_tile(const float* __restrict__ src, int ldsrc, u16* __restrict__ dst, int K, int k0, int n0, bool perm,
                    const float* __restrict__ rowscale, char* lds) {
  float* tile = (float*)lds;
  const int tid = otid();
  __syncthreads();
  const int c = tid & 63, r0 = tid >> 6;
  const int ncol = perm ? winmap(n0 + c) : (n0 + c);
#pragma unroll
  for (int i = 0; i < 8; ++i) {
    const int r = r0 + 8 * i;
    float v = ncol >= 0 ? src[(size_t)(k0 + r) * ldsrc + ncol] : 0.f;
    if (rowscale) v *= rowscale[k0 + r];
    tile[r * 65 + c] = v;
  }
  __syncthreads();
  {
    const int idx = tid, n = idx >> 3, ch = idx & 7;
    float e[8];
#pragma unroll
    for (int q = 0; q < 8; ++q) e[q] = tile[(ch * 8 + q) * 65 + n];
    *(bf16x8*)(dst + (size_t)(n0 + n) * K + k0 + ch * 8) = pack8(e[0], e[1], e[2], e[3], e[4], e[5], e[6], e[7]);
  }
}

DI void phaseW(const KArgs& ka, char* lds) {
  const Params p = make_params(ka);
  const int tid = otid(), nb = gridDim.x, bid = blockIdx.x;
  for (int i = bid * NTH + tid; i < 11 * T; i += nb * NTH) p.sumsq_x[T + i] = 0.f;
  for (int i = bid * NTH + tid; i < 8192 * 16; i += nb * NTH) {
    const int pos = i >> 4, j = i & 15;
    float fh = 1.f, fl = 0.f;
#pragma unroll
    for (int q = 1; q < 16; ++q) {
      constexpr double Bq[4] = {1.0, 0.5623413251903491, 0.31622776601683794, 0.1778279410038923};
      constexpr double Pq[4] = {1.0, 0.1, 0.01, 0.001};
      const double f = Bq[q & 3] * Pq[q >> 2];
      const float h_ = (float)f; const float l_ = (float)(f - (double)h_);
      if (j == q) { fh = h_; fl = l_; }
    }
    const float fp = (float)pos;
    const float a = fp * fh, e = fmaf(fp, fh, -a), alo = fmaf(fp, fl, e);
    const float k = rintf(a * 0.15915494309189535f);
    float r = fmaf(-k, 6.28125f, a);
    r = fmaf(-k, 0.0019340515136718750f, r);
    r = fmaf(-k, 1.2556659146020e-06f, r);
    r += alo;
    p.rope[i] = make_float2(cosf(r), sinf(r));
  }
  {
    const int wave = __builtin_amdgcn_readfirstlane(tid >> 6), lane = tid & 63;
    for (int row = bid * NWV + wave; row < T; row += nb * NWV) {
      const float* xr = p.x + (size_t)row * 1024;
      float ss = 0.f;
#pragma unroll
      for (int j = 0; j < 4; ++j) {
        const int c = lane * 4 + 256 * j;
        const float4 v = *(const float4*)(xr + c);
        const float4 g = *(const float4*)(p.norm_g + c);
        ss += v.x * v.x + v.y * v.y + v.z * v.z + v.w * v.w;
        st4(p.xg + (size_t)row * 1024 + c, v.x * g.x, v.y * g.y, v.z * g.z, v.w * g.w);
      }
#pragma unroll
      for (int o = 32; o >= 1; o >>= 1) ss += __shfl_xor(ss, o, 64);
      if (lane == 0) p.sumsq_x[row] = ss;
    }
  }
  constexpr int N_IN = DEPTH * 16 * 46, N_OUT = DEPTH * 16 * 16, N_QU = DEPTH * 4 * 9, N_KV = DEPTH * 2 * 12;
  for (int it = bid; it < N_IN + N_OUT + N_QU + N_KV; it += nb) {
    if (it < N_IN) {
      const int l = it / (16 * 46), r = it % (16 * 46), kt = r / 46, nt = r % 46;
      wtrans_tile(p.w_in + (size_t)l * 1024 * NIN, NIN, p.WinT + (size_t)l * NINP * 1024, 1024, kt * 64, nt * 64, true, nullptr, lds);
    } else if (it < N_IN + N_OUT) {
      const int i2 = it - N_IN, l = i2 / 256, r = i2 % 256, kt = r / 16, nt = r % 16;
      wtrans_tile(p.w_out + (size_t)l * 1024 * 1024, 1024, p.WoutT + (size_t)l * 1024 * 1024, 1024, kt * 64, nt * 64, false, nullptr, lds);
    } else if (it < N_IN + N_OUT + N_QU) {
      const int i2 = it - N_IN - N_OUT, l = i2 / 36, r = i2 % 36, kt = r / 9, nt = r % 9;
      wtrans_tile(p.w_qup + (size_t)l * 256 * 576, 576, p.WqupT + (size_t)l * 576 * 256, 256, kt * 64, nt * 64, false, p.bql_g + l * 256, lds);
    } else {
      const int i2 = it - N_IN - N_OUT - N_QU, l = i2 / 24, r = i2 % 24, kt = r / 12, nt = r % 12;
      wtrans_tile(p.w_kvup + (size_t)l * 128 * 768, 768, p.WkvupT + (size_t)l * 768 * 128, 128, kt * 64, nt * 64, false, p.bkvl_g + l * 128, lds);
    }
  }
}

struct ALoadPlain {
  const u16* A; int lda;
  DI bf16x8 operator()(int row, int kcol) const { return *(const bf16x8*)(A + (size_t)row * lda + kcol); }
};
struct ALoadY {
  const u16* y; const u16* part; const float* lA; const u16* gate;
  DI bf16x8 operator()(int row, int kcol) const {
    if (kcol >= 256) return *(const bf16x8*)(y + (size_t)row * 1024 + kcol);
    const int head = kcol >> 6;
    float o[8] = {0, 0, 0, 0, 0, 0, 0, 0}; float l = 0.f;
#pragma unroll
    for (int pt = 0; pt < 3; ++pt) {
      const uint4 u = *(const uint4*)(part + ((size_t)pt * T + row) * 256 + kcol);
      o[0] += bflo(u.x); o[1] += bfhi(u.x); o[2] += bflo(u.y); o[3] += bfhi(u.y);
      o[4] += bflo(u.z); o[5] += bfhi(u.z); o[6] += bflo(u.w); o[7] += bfhi(u.w);
      l += lA[((size_t)pt * T + row) * 4 + head];
    }
    const uint4 g = *(const uint4*)(gate + (size_t)row * 1024 + kcol);
    const float inv = 1.f / l;
    return pack8(o[0] * inv * bflo(g.x), o[1] * inv * bfhi(g.x), o[2] * inv * bflo(g.y), o[3] * inv * bfhi(g.y),
                 o[4] * inv * bflo(g.z), o[5] * inv * bfhi(g.z), o[6] * inv * bflo(g.w), o[7] * inv * bfhi(g.w));
  }
};

template <int NB>
DI void gemm_tile(const u16* __restrict__ A, int lda, const u16* __restrict__ Wt, int K, int m0, int n0, char* lds, f32x16 (&acc)[2][NB]) {
  const int tid = otid(), wave = __builtin_amdgcn_readfirstlane(tid >> 6), lane = tid & 63, r32 = lane & 31, h = lane >> 5;
  const int wm = wave >> 1, wn = wave & 1;
  constexpr int STG = 32768 + NB * 8192;
#pragma unroll
  for (int a = 0; a < 2; ++a)
#pragma unroll
    for (int b = 0; b < NB; ++b)
#pragma unroll
      for (int i = 0; i < 16; ++i) acc[a][b][i] = 0.f;
  const int nk = K >> 6;
  int asrc[4], wsrc[NB];
#pragma unroll
  for (int q = 0; q < 4; ++q) { const int P = (wave * 4 + q) * 64 + lane, row = P >> 3, cp = P & 7; asrc[q] = (m0 + row) * lda + ((cp ^ ((row >> 1) & 7)) << 3); }
#pragma unroll
  for (int q = 0; q < NB; ++q) { const int P = (wave * NB + q) * 64 + lane, row = P >> 3, cp = P & 7; wsrc[q] = (n0 + row) * K + ((cp ^ ((row >> 1) & 7)) << 3); }
  auto stage = [&](int kt, char* buf) {
#pragma unroll
    for (int q = 0; q < 4; ++q)
      __builtin_amdgcn_global_load_lds((const unsigned*)(A + (size_t)asrc[q] + kt * 64), (unsigned __attribute__((address_space(3)))*)(buf + (wave * 4 + q) * 1024), 16, 0, 0);
#pragma unroll
    for (int q = 0; q < NB; ++q)
      __builtin_amdgcn_global_load_lds((const unsigned*)(Wt + (size_t)wsrc[q] + kt * 64), (unsigned __attribute__((address_space(3)))*)(buf + 32768 + (wave * NB + q) * 1024), 16, 0, 0);
  };
  __syncthreads();
  stage(0, lds);
  asm volatile("s_waitcnt vmcnt(0)" ::: "memory");
  __syncthreads();
#pragma unroll 1
  for (int kt = 0; kt < nk; ++kt) {
    char* buf = lds + (kt & 1) * STG;
    char* nbuf = lds + ((kt + 1) & 1) * STG;
    if (kt + 1 < nk) stage(kt + 1, nbuf);
#pragma unroll
    for (int s = 0; s < 4; ++s) {
      bf16x8 af[2], wf[NB];
#pragma unroll
      for (int a = 0; a < 2; ++a) af[a] = *(const bf16x8*)(buf + swz(wm * 64 + a * 32 + r32, 2 * s + h));
#pragma unroll
      for (int b = 0; b < NB; ++b) wf[b] = *(const bf16x8*)(buf + 32768 + swz(wn * NB * 32 + b * 32 + r32, 2 * s + h));
#pragma unroll
      for (int a = 0; a < 2; ++a)
#pragma unroll
        for (int b = 0; b < NB; ++b) acc[a][b] = MFMA32(wf[b], af[a], acc[a][b]);
    }
    asm volatile("s_waitcnt vmcnt(0)" ::: "memory");
    __syncthreads();
  }
}

DI int swz64(int row, int ch) { return row * 64 + ((ch ^ ((row >> 2) & 3)) << 4); }
DI void gemm_tile4(const u16* __restrict__ A, int lda, const u16* __restrict__ Wt, int K, int m0, int n0, char* lds, f32x16 (&acc)[2][4]) {
  const int tid = otid(), wave = __builtin_amdgcn_readfirstlane(tid >> 6), lane = tid & 63, r32 = lane & 31, h = lane >> 5;
  const int wm = wave >> 1, wn = wave & 1;
  constexpr int STG = 16384 + 16384;
#pragma unroll
  for (int a = 0; a < 2; ++a)
#pragma unroll
    for (int b = 0; b < 4; ++b)
#pragma unroll
      for (int i = 0; i < 16; ++i) acc[a][b][i] = 0.f;
  const int nk = K >> 5;
  int asrc[2], wsrc[2];
#pragma unroll
  for (int q = 0; q < 2; ++q) { const int P = (wave * 2 + q) * 64 + lane, row = P >> 2, cp = P & 3; asrc[q] = (m0 + row) * lda + ((cp ^ ((row >> 2) & 3)) << 3); }
#pragma unroll
  for (int q = 0; q < 2; ++q) { const int P = (wave * 2 + q) * 64 + lane, row = P >> 2, cp = P & 3; wsrc[q] = (n0 + row) * K + ((cp ^ ((row >> 2) & 3)) << 3); }
  auto stage = [&](int kt, char* buf) {
#pragma unroll
    for (int q = 0; q < 2; ++q)
      __builtin_amdgcn_global_load_lds((const unsigned*)(A + (size_t)asrc[q] + kt * 32), (unsigned __attribute__((address_space(3)))*)(buf + (wave * 2 + q) * 1024), 16, 0, 0);
#pragma unroll
    for (int q = 0; q < 2; ++q)
      __builtin_amdgcn_global_load_lds((const unsigned*)(Wt + (size_t)wsrc[q] + kt * 32), (unsigned __attribute__((address_space(3)))*)(buf + 16384 + (wave * 2 + q) * 1024), 16, 0, 0);
  };
  __syncthreads();
  stage(0, lds); stage(1, lds + STG);
  bf16x8 af0[2], wf0[4], af1[2], wf1[4];
  auto rd = [&](const char* buf, int s, bf16x8 (&af)[2], bf16x8 (&wf)[4]) {
#pragma unroll
    for (int a = 0; a < 2; ++a) af[a] = *(const bf16x8*)(buf + swz64(wm * 64 + a * 32 + r32, 2 * s + h));
#pragma unroll
    for (int b = 0; b < 4; ++b) wf[b] = *(const bf16x8*)(buf + 16384 + swz64(wn * 128 + b * 32 + r32, 2 * s + h));
  };
  auto mm = [&](const bf16x8 (&af)[2], const bf16x8 (&wf)[4]) {
#pragma unroll
    for (int a = 0; a < 2; ++a)
#pragma unroll
      for (int b = 0; b < 4; ++b) acc[a][b] = MFMA32(wf[b], af[a], acc[a][b]);
  };
  int cur = 0;
#pragma unroll 1
  for (int kt = 0; kt < nk; ++kt) {
    if (kt + 1 < nk) asm volatile("s_waitcnt vmcnt(4)" ::: "memory"); else asm volatile("s_waitcnt vmcnt(0)" ::: "memory");
    asm volatile("s_waitcnt lgkmcnt(0)" ::: "memory"); __builtin_amdgcn_s_barrier(); asm volatile("" ::: "memory");
    const char* buf = lds + cur * STG;
    { const int nx2 = cur == 0 ? 2 : cur - 1; if (kt + 2 < nk) stage(kt + 2, lds + nx2 * STG); }
    rd(buf, 0, af0, wf0);
    if (kt > 0) mm(af1, wf1);
    rd(buf, 1, af1, wf1);
    mm(af0, wf0);
#ifndef NO_SGB4
    __builtin_amdgcn_sched_group_barrier(0x100, 6, 0);
    __builtin_amdgcn_sched_group_barrier(0x008, 8, 0);
    __builtin_amdgcn_sched_group_barrier(0x100, 6, 0);
    __builtin_amdgcn_sched_group_barrier(0x008, 8, 0);
#endif
    cur = cur == 2 ? 0 : cur + 1;
  }
  mm(af1, wf1);
  asm volatile("s_waitcnt lgkmcnt(0)" ::: "memory"); __builtin_amdgcn_s_barrier(); asm volatile("" ::: "memory");
}

constexpr int WREG = 20480;
DI void stg4(char* wl, int rs, int trow, int colbyte, float a, float b, float c, float e) {
  *(uint2*)(wl + trow * rs + colbyte) = make_uint2(pk(a, b), pk(c, e));
}
template <int CH>
DI void flush_rows(const char* wl, int rs, int lane, char* dst0, size_t dstride) {
  asm volatile("" : "+v"(lane));
#pragma unroll
  for (int j = 0; j < CH; ++j) {
    const int idx = j * 64 + lane, row = idx / CH, ch = idx % CH;
    const uint4 t = *(const uint4*)(wl + row * rs + ch * 16);
    *(uint4*)(dst0 + (size_t)row * dstride + ch * 16) = t;
  }
}
DI void epi_gemm1(const Params& p, int l, const f32x16& a0, const f32x16& a1, int token, int trow, int cb, int h, char* wl) {
  constexpr int RS = 144;
  const int sp = token & 8191;
  const float rs = rsqrtf(p.sumsq_x[l * T + token] * (1.f / 1024.f) + EPS);
  float v[2][16];
#pragma unroll
  for (int i = 0; i < 16; ++i) { v[0][i] = a0[i] * rs; v[1][i] = a1[i] * rs; }
  if (cb < 512 || (cb >= 1792 && cb < 2304)) {
    float ss = 0.f;
#pragma unroll
    for (int i = 0; i < 16; ++i) ss += v[0][i] * v[0][i] + v[1][i] * v[1][i];
    ss = xsum32(ss);
    const float r = rsqrtf(ss * (1.f / 64.f) + EPS);
    const float* g; float qs = 1.f; bool rope = false;
    if (cb < 256)       { g = p.aq_g + l * 64; qs = QSCALE64; }
    else if (cb < 512)  { g = p.ak_g + l * 64; }
    else if (cb < 2176) { g = p.cq_g + l * 64; qs = QSCALE64; rope = true; }
    else                { g = p.ck_g + l * 64; rope = true; }
    const float rq = r * qs;
#pragma unroll
    for (int nb = 0; nb < 2; ++nb)
#pragma unroll
      for (int g4 = 0; g4 < 4; ++g4) {
        const float4 gg = *(const float4*)(g + nb * 32 + 8 * g4 + 4 * h);
        v[nb][4 * g4] *= rq * gg.x; v[nb][4 * g4 + 1] *= rq * gg.y; v[nb][4 * g4 + 2] *= rq * gg.z; v[nb][4 * g4 + 3] *= rq * gg.w;
      }
    if (rope) {
#pragma unroll
      for (int nb = 0; nb < 2; ++nb) {
        const int pos = nb == 0 ? (sp >> 6) : (sp & 63);
#pragma unroll
        for (int i = 0; i < 8; ++i) {
          const float2 cs = p.rope[pos * 16 + crow(i, h)];
          const float x1 = v[nb][i], x2 = v[nb][i + 8];
          v[nb][i] = x1 * cs.x - x2 * cs.y; v[nb][i + 8] = x2 * cs.x + x1 * cs.y;
        }
      }
    }
  } else if ((cb >= 512 && cb < 768) || (cb >= 2304 && cb < 2432)) {
  } else if (cb >= 1024 && cb < 1408) {
    float ss = 0.f;
#pragma unroll
    for (int i = 0; i < 16; ++i) ss += v[0][i] * v[0][i] + v[1][i] * v[1][i];
    ss = xsum32(ss);
    if (h == 0) atomicAdd((cb < 1280 ? p.ss_ql : p.ss_kvl) + l * T + token, ss);
  } else if (cb == 2816) {
    float ss = 0.f;
#pragma unroll
    for (int i = 0; i < 16; ++i) ss += v[0][i] * v[0][i];
    ss = xsum32(ss);
    if (h == 0) p.kpe_ss[token] = ss;
    const float* g = p.bk_g + l * 96 + 64;
#pragma unroll
    for (int i = 0; i < 8; ++i) {
      const int j = crow(i, h);
      const float2 cs = p.rope[sp * 16 + j];
      const float x1 = v[0][i] * g[j], x2 = v[0][i + 8] * g[16 + j];
      v[0][i] = x1 * cs.x - x2 * cs.y; v[0][i + 8] = x2 * cs.x + x1 * cs.y;
    }
#pragma unroll
    for (int g4 = 0; g4 < 4; ++g4)
      *(float4*)(wl + trow * RS + (8 * g4 + 4 * h) * 4) = make_float4(v[0][4 * g4], v[0][4 * g4 + 1], v[0][4 * g4 + 2], v[0][4 * g4 + 3]);
    return;
  } else {
#pragma unroll
    for (int nb = 0; nb < 2; ++nb)
#pragma unroll
      for (int i = 0; i < 16; ++i) { const float x = v[nb][i]; v[nb][i] = x * __builtin_amdgcn_rcpf(1.f + __builtin_amdgcn_exp2f(-LOG2E * x)); }
  }
#pragma unroll
  for (int nb = 0; nb < 2; ++nb)
#pragma unroll
    for (int g4 = 0; g4 < 4; ++g4)
      stg4(wl, RS, trow, (nb * 32 + 8 * g4 + 4 * h) * 2, v[nb][4 * g4], v[nb][4 * g4 + 1], v[nb][4 * g4 + 2], v[nb][4 * g4 + 3]);
}

DI void gemm1_flush(const Params& p, int cb, int token0, const char* wl, int lane) {
  const int b = token0 >> 13, sp0 = token0 & 8191;
  char* dst; size_t dstride;
  if (cb < 256)       { dst = (char*)(p.Qa + ((size_t)(b * 4 + (cb >> 6)) * S + sp0) * 64); dstride = 128; }
  else if (cb < 512)  { dst = (char*)(p.Ka + ((size_t)(b * 4 + ((cb - 256) >> 6)) * S + sp0) * 64); dstride = 128; }
  else if (cb < 768)  { dst = (char*)(p.Va + ((size_t)(b * 4 + ((cb - 512) >> 6)) * S + sp0) * 64); dstride = 128; }
  else if (cb < 1024) { dst = (char*)(p.Gate + (size_t)token0 * 1024 + (cb - 768)); dstride = 2048; }
  else if (cb < 1280) { dst = (char*)(p.qlat + (size_t)token0 * 256 + (cb - 1024)); dstride = 512; }
  else if (cb < 1408) { dst = (char*)(p.kvlat + (size_t)token0 * 128 + (cb - 1280)); dstride = 256; }
  else if (cb < 1792) { dst = (char*)(p.Gate + (size_t)token0 * 1024 + 256 + (cb - 1408)); dstride = 2048; }
  else if (cb < 2176) { dst = (char*)(p.Qc + ((size_t)(b * 6 + ((cb - 1792) >> 6)) * S + sp0) * 64); dstride = 128; }
  else if (cb < 2304) { dst = (char*)(p.Kc + ((size_t)(b * 2 + ((cb - 2176) >> 6)) * S + sp0) * 64); dstride = 128; }
  else if (cb < 2432) { dst = (char*)(p.Vc + ((size_t)(b * 2 + ((cb - 2304) >> 6)) * S + sp0) * 64); dstride = 128; }
  else if (cb < 2816) { dst = (char*)(p.Gate + (size_t)token0 * 1024 + 640 + (cb - 2432)); dstride = 2048; }
  else                { dst = (char*)(p.R + (size_t)token0 * 32); dstride = 128; }
  flush_rows<8>(wl, 144, lane, dst, dstride);
}

DI void phase_gemm1(const KArgs& ka, int l, char* lds) {
  const Params p = make_params(ka);
  const int tid = otid(), wave = __builtin_amdgcn_readfirstlane(tid >> 6), lane = tid & 63, r32 = lane & 31, h = lane >> 5;
  const int wm = wave >> 1, wn = wave & 1;
  const u16* Wt = p.WinT + (size_t)l * NINP * 1024;
  char* wl = lds + wave * WREG;
  const int xcd = blockIdx.x & 7, jb = blockIdx.x >> 3, nbx = gridDim.x >> 3;
  for (int q = jb; q < 192; q += nbx) {
    const int mt = xcd * 16 + (q & 15), nt = q >> 4;
    const int token0 = mt * 256 + wm * 64;
    if (nt < 11) {
      f32x16 acc[2][4];
      gemm_tile<4>(p.xg, 1024, Wt, 1024, mt * 256, nt * 256, lds, acc);
#pragma unroll
      for (int hf = 0; hf < 2; ++hf) {
        const int cb = nt * 256 + wn * 128 + hf * 64;
#pragma unroll
        for (int a = 0; a < 2; ++a) epi_gemm1(p, l, acc[a][2 * hf], acc[a][2 * hf + 1], token0 + a * 32 + r32, a * 32 + r32, cb, h, wl);
        gemm1_flush(p, cb, token0, wl, lane);
      }
    } else {
      f32x16 acc[2][2];
      gemm_tile<2>(p.xg, 1024, Wt, 1024, mt * 256, 2816, lds, acc);
      const int cb = 2816 + wn * 64;
      if (cb >= 2880) continue;
#pragma unroll
      for (int a = 0; a < 2; ++a) epi_gemm1(p, l, acc[a][0], acc[a][1], token0 + a * 32 + r32, a * 32 + r32, cb, h, wl);
      gemm1_flush(p, cb, token0, wl, lane);
    }
  }
}

DI void attn_a_block(const Params& p, int b, int head, int pat, int grp, char* lds) {
  const int tid = otid(), wave = __builtin_amdgcn_readfirstlane(tid >> 6), lane = tid & 63, r32 = lane & 31, h = lane >> 5;
  const int sh = 2 * pat, dil = 1 << sh, L = S >> sh, L32s = 8 - sh;
  const int wi0 = grp * 8, r = wi0 >> L32s, lb0 = (wi0 & ((1 << L32s) - 1)) * 32;
  const int l0 = lb0 + wave * 32, lbase = lb0 - 64;
  const size_t hb = (size_t)(b * 4 + head) * S;
  const u16* Qh = p.Qa + hb * 64; const u16* Kh = p.Ka + hb * 64; const u16* Vh = p.Va + hb * 64;
  char* Kimg = lds; char* Vimg = lds + 384 * 128;
#pragma unroll
  for (int q = 0; q < 6; ++q) {
    const int P = (wave * 6 + q) * 64 + lane, row = P >> 3, cp = P & 7;
    int lk = lbase + row; lk = lk < 0 ? 0 : (lk >= L ? L - 1 : lk);
    const size_t tok = (size_t)((lk << sh) + r) * 64;
    __builtin_amdgcn_global_load_lds((const unsigned*)(Kh + tok + ((cp ^ ((row >> 1) & 7)) << 3)), (unsigned __attribute__((address_space(3)))*)(Kimg + (wave * 6 + q) * 1024), 16, 0, 0);
    __builtin_amdgcn_global_load_lds((const unsigned*)(Vh + tok + ((cp ^ (((row >> 1) & 1) << 2)) << 3)), (unsigned __attribute__((address_space(3)))*)(Vimg + (wave * 6 + q) * 1024), 16, 0, 0);
  }
  bf16x8 qf[4];
  const int tq = ((l0 + r32) << sh) + r;
#pragma unroll
  for (int s = 0; s < 4; ++s) qf[s] = *(const bf16x8*)(Qh + (size_t)tq * 64 + 16 * s + 8 * h);
  f32x16 O0, O1;
#pragma unroll
  for (int i = 0; i < 16; ++i) { O0[i] = 0.f; O1[i] = 0.f; }
  float ls = 0.f;
  const float slope2 = exp2f(-2.f * (float)(head + 1)) * (float)dil * LOG2E;
  const float basef = (float)(4 * h - r32);
  const bool edge = (lbase < 0) || (lbase + 384 > L);
  const int i16 = lane & 15, qq = i16 >> 2, pp = i16 & 3, blk = (lane >> 4) & 1, sw = (qq >> 1) & 1;
  const int vb0 = (4 * h + qq) * 128 + ((0 ^ sw) << 6) + (16 * blk + 4 * pp) * 2;
  const int vb1 = (4 * h + qq) * 128 + ((1 ^ sw) << 6) + (16 * blk + 4 * pp) * 2;
  asm volatile("s_waitcnt vmcnt(0)" ::: "memory");
  __syncthreads();
#pragma unroll
  for (int kb = 0; kb < 5; ++kb) {
    const int rowb = wave * 32 + kb * 32;
    const int ks = l0 - 64 + 32 * kb;
    f32x16 Sx;
#pragma unroll
    for (int i = 0; i < 16; ++i) Sx[i] = 0.f;
#pragma unroll
    for (int s = 0; s < 4; ++s) {
      const bf16x8 kf = *(const bf16x8*)(Kimg + swz(rowb + r32, 2 * s + h));
      Sx = MFMA32(kf, qf[s], Sx);
    }
#pragma unroll
    for (int i = 0; i < 16; ++i) {
      const float dlf = (float)(32 * kb - 64 + (i & 3) + 8 * (i >> 2)) + basef;
      float pv = __builtin_amdgcn_exp2f(fmaf(-slope2, fabsf(dlf), Sx[i]));
      if (kb == 0 || kb == 4) pv = (fabsf(dlf) <= 64.f) ? pv : 0.f;
      Sx[i] = pv;
    }
    if (edge) {
#pragma unroll
      for (int i = 0; i < 16; ++i) { const int lkey = ks + crow(i, h); Sx[i] = (lkey >= 0 && lkey < L) ? Sx[i] : 0.f; }
    }
#pragma unroll
    for (int i = 0; i < 16; ++i) ls += Sx[i];
    bf16x8 pf[2];
#pragma unroll
    for (int st = 0; st < 2; ++st)
      pf[st] = pack8(Sx[8 * st], Sx[8 * st + 1], Sx[8 * st + 2], Sx[8 * st + 3], Sx[8 * st + 4], Sx[8 * st + 5], Sx[8 * st + 6], Sx[8 * st + 7]);
#pragma unroll
    for (int st = 0; st < 2; ++st) {
      const char* v0 = Vimg + vb0 + (rowb + st * 16) * 128;
      const char* v1 = Vimg + vb1 + (rowb + st * 16) * 128;
      const bf16x8 vf0 = cat4(trread(v0), trread(v0 + 8 * 128));
      const bf16x8 vf1 = cat4(trread(v1), trread(v1 + 8 * 128));
      O0 = MFMA32(vf0, pf[st], O0);
      O1 = MFMA32(vf1, pf[st], O1);
    }
  }
  const float lt = xsum32(ls);
  const size_t token = (size_t)b * S + tq;
  u16* d = p.PartA + ((size_t)pat * T + token) * 256 + head * 64;
#pragma unroll
  for (int g4 = 0; g4 < 4; ++g4) {
    st4(d + 8 * g4 + 4 * h, O0[4 * g4], O0[4 * g4 + 1], O0[4 * g4 + 2], O0[4 * g4 + 3]);
    st4(d + 32 + 8 * g4 + 4 * h, O1[4 * g4], O1[4 * g4 + 1], O1[4 * g4 + 2], O1[4 * g4 + 3]);
  }
  if (h == 0) p.lA[((size_t)pat * T + token) * 4 + head] = lt;
}

DI void phase_mla_up(const KArgs& ka, int l, char* lds) {
  const Params p = make_params(ka);
  const int tid = otid(), wave = __builtin_amdgcn_readfirstlane(tid >> 6), lane = tid & 63, r32 = lane & 31, h = lane >> 5;
  const int wm = wave >> 1, wn = wave & 1;
  const int xcd = blockIdx.x & 7, jb = blockIdx.x >> 3, nbx = gridDim.x >> 3;
  for (int q = jb; q < 144 + 192; q += nbx) {
    if (q >= 144) {
      __syncthreads();
      const int q3 = q - 144, bh = xcd * 2 + q3 / 96, r3 = q3 % 96, pat = r3 >> 5, grp = r3 & 31;
      attn_a_block(p, bh >> 2, bh & 3, pat, grp, lds);
      continue;
    }
    const int mtl = q / 9, cc = q % 9;
    if (cc < 3) {
      const int mt = xcd * 16 + mtl, nt = cc;
      f32x16 acc[2][3];
      gemm_tile<3>(p.qlat, 256, p.WqupT + (size_t)l * 576 * 256, 256, mt * 256, nt * 192, lds, acc);
      const int head = nt * 2 + wn;
      const float* g = p.bq_g + l * 96;
#pragma unroll
      for (int a = 0; a < 2; ++a) {
        const int token = mt * 256 + wm * 64 + a * 32 + r32, b = token >> 13, sp = token & 8191;
        const float rs = rsqrtf(p.ss_ql[l * T + token] * (1.f / 256.f) + EPS);
        float v[3][16]; float ss = 0.f;
#pragma unroll
        for (int nb = 0; nb < 3; ++nb)
#pragma unroll
          for (int i = 0; i < 16; ++i) { v[nb][i] = acc[a][nb][i] * rs; ss += v[nb][i] * v[nb][i]; }
        ss = xsum32(ss);
        const float r = rsqrtf(ss * (1.f / 96.f) + EPS);
#pragma unroll
        for (int nb = 0; nb < 3; ++nb)
#pragma unroll
          for (int i = 0; i < 16; ++i) v[nb][i] *= r * g[nb * 32 + crow(i, h)];
#pragma unroll
        for (int i = 0; i < 8; ++i) {
          const float2 cs = p.rope[sp * 16 + crow(i, h)];
          const float x1 = v[2][i], x2 = v[2][i + 8];
          v[2][i] = x1 * cs.x - x2 * cs.y; v[2][i + 8] = x2 * cs.x + x1 * cs.y;
        }
        u16* d = p.Qb + ((size_t)(b * 6 + head) * S + sp) * 96;
#pragma unroll
        for (int nb = 0; nb < 3; ++nb)
#pragma unroll
          for (int g4 = 0; g4 < 4; ++g4)
            st4(d + nb * 32 + 8 * g4 + 4 * h, v[nb][4 * g4] * QSCALE96, v[nb][4 * g4 + 1] * QSCALE96, v[nb][4 * g4 + 2] * QSCALE96, v[nb][4 * g4 + 3] * QSCALE96);
      }
    } else {
      const int mt = xcd * 16 + mtl, head = cc - 3;
      f32x16 acc[2][2];
      gemm_tile<2>(p.kvlat, 128, p.WkvupT + (size_t)l * 768 * 128, 128, mt * 256, head * 128, lds, acc);
      const float* g = p.bk_g + l * 96;
#pragma unroll
      for (int a = 0; a < 2; ++a) {
        const int token = mt * 256 + wm * 64 + a * 32 + r32, b = token >> 13, sp = token & 8191;
        const float rs = rsqrtf(p.ss_kvl[l * T + token] * (1.f / 128.f) + EPS);
        if (wn == 0) {
          float ss = 0.f;
#pragma unroll
          for (int nb = 0; nb < 2; ++nb)
#pragma unroll
            for (int i = 0; i < 16; ++i) { const float t = acc[a][nb][i] * rs; ss += t * t; }
          ss = xsum32(ss) + p.kpe_ss[token];
          const float r = rsqrtf(ss * (1.f / 96.f) + EPS);
          u16* dk = p.Kb + ((size_t)(b * 6 + head) * S + sp) * 96;
          const float rr = rs * r;
#pragma unroll
          for (int nb = 0; nb < 2; ++nb)
#pragma unroll
            for (int g4 = 0; g4 < 4; ++g4) {
              const int c = nb * 32 + 8 * g4 + 4 * h;
              st4(dk + c, acc[a][nb][4 * g4] * rr * g[c], acc[a][nb][4 * g4 + 1] * rr * g[c + 1], acc[a][nb][4 * g4 + 2] * rr * g[c + 2], acc[a][nb][4 * g4 + 3] * rr * g[c + 3]);
            }
          const float* Rr = p.R + (size_t)token * 32 + 16 * h;
#pragma unroll
          for (int q = 0; q < 4; ++q) {
            const float4 t = *(const float4*)(Rr + 4 * q);
            st4(dk + 64 + 16 * h + 4 * q, t.x * r, t.y * r, t.z * r, t.w * r);
          }
        } else {
          u16* dv = p.Vb + ((size_t)(b * 6 + head) * S + sp) * 64;
#pragma unroll
          for (int nb = 0; nb < 2; ++nb)
#pragma unroll
            for (int g4 = 0; g4 < 4; ++g4) {
              const int c = nb * 32 + 8 * g4 + 4 * h;
              st4(dv + c, acc[a][nb][4 * g4] * rs, acc[a][nb][4 * g4 + 1] * rs, acc[a][nb][4 * g4 + 2] * rs, acc[a][nb][4 * g4 + 3] * rs);
            }
        }
      }
    }
  }
}

DI void phase_outproj(const KArgs& ka, int l, char* lds) {
  const Params p = make_params(ka);
  const int tid = otid(), wave = __builtin_amdgcn_readfirstlane(tid >> 6), lane = tid & 63, r32 = lane & 31, h = lane >> 5;
  const int wm = wave >> 1, wn = wave & 1;
  const u16* Wt = p.WoutT + (size_t)l * 1024 * 1024;
  const float* xin = (l == 0) ? p.x : p.out;
  char* wl = lds + wave * WREG;
  constexpr int RS = 272;
  const int xcd = blockIdx.x & 7, jb = blockIdx.x >> 3, nbx = gridDim.x >> 3;
  for (int q = jb; q < 64; q += nbx) {
    const int mt = xcd * 16 + (q & 15), nt = q >> 4;
    f32x16 acc[2][4];
    gemm_tile<4>(p.y, 1024, Wt, 1024, mt * 256, nt * 256, lds, acc);
    const int token0 = mt * 256 + wm * 64;
#pragma unroll
    for (int hf = 0; hf < 2; ++hf) {
      const int col0 = nt * 256 + wn * 128 + hf * 64;
#pragma unroll
      for (int a = 0; a < 2; ++a)
#pragma unroll
        for (int nb = 0; nb < 2; ++nb)
#pragma unroll
          for (int g4 = 0; g4 < 4; ++g4)
            *(float4*)(wl + (a * 32 + r32) * RS + (nb * 32 + 8 * g4 + 4 * h) * 4) =
                make_float4(acc[a][2 * hf + nb][4 * g4], acc[a][2 * hf + nb][4 * g4 + 1], acc[a][2 * hf + nb][4 * g4 + 2], acc[a][2 * hf + nb][4 * g4 + 3]);
      int ln = lane; asm volatile("" : "+v"(ln));
      const int ch = ln & 15;
      float4 g = make_float4(0.f, 0.f, 0.f, 0.f);
      if (l < DEPTH - 1) g = *(const float4*)(p.norm_g + (l + 1) * 1024 + col0 + ch * 4);
#pragma unroll 4
      for (int j = 0; j < 16; ++j) {
        const int row = j * 4 + (ln >> 4);
        const float4 av = *(const float4*)(wl + row * RS + ch * 16);
        const size_t go = (size_t)(token0 + row) * 1024 + col0 + ch * 4;
        float4 xo = *(const float4*)(xin + go);
        xo.x += av.x; xo.y += av.y; xo.z += av.z; xo.w += av.w;
        *(float4*)(p.out + go) = xo;
        if (l < DEPTH - 1) {
          float ss = xo.x * xo.x + xo.y * xo.y + xo.z * xo.z + xo.w * xo.w;
          st4(p.xg + go, xo.x * g.x, xo.y * g.y, xo.z * g.z, xo.w * g.w);
          ss += __shfl_xor(ss, 1, 64); ss += __shfl_xor(ss, 2, 64); ss += __shfl_xor(ss, 4, 64); ss += __shfl_xor(ss, 8, 64);
          if (ch == 0) atomicAdd(p.sumsq_x + (l + 1) * T + token0 + row, ss);
        }
      }
    }
  }
}

template <int DK>
DI void attn_dense_item(const u16* __restrict__ Qh, const u16* __restrict__ Kh, const u16* __restrict__ Vh,
                        const u16* __restrict__ gate, u16* __restrict__ yout, char* lds) {
  constexpr int KCH = DK / 8, NS = DK / 16;
  constexpr int KT = 256;
  constexpr int KBYTES = KT * DK * 2, BUF = KBYTES + KT * 128;
  constexpr int NKI = KT * KCH / 64 / NWV;
  constexpr int NVI = KT * 8 / 64 / NWV;
  const int tid = otid(), wave = __builtin_amdgcn_readfirstlane(tid >> 6), lane = tid & 63, r32 = lane & 31, h = lane >> 5;
  auto kswz = [&](int row) { return (DK == 64) ? ((row >> 1) & 7) : ((row >> 2) & 3); };
  auto koff = [&](int row, int ch) { return row * (DK * 2) + ((ch ^ kswz(row)) << 4); };
  bf16x8 qf[2][NS];
#pragma unroll
  for (int qb = 0; qb < 2; ++qb)
#pragma unroll
    for (int s = 0; s < NS; ++s) qf[qb][s] = *(const bf16x8*)(Qh + (size_t)(wave * 64 + qb * 32 + r32) * DK + s * 16 + h * 8);
  f32x16 O[2][2];
#pragma unroll
  for (int a = 0; a < 2; ++a)
#pragma unroll
    for (int b = 0; b < 2; ++b)
#pragma unroll
      for (int i = 0; i < 16; ++i) O[a][b][i] = 0.f;
  typedef __attribute__((ext_vector_type(4))) float f32x4_;
  f32x4_ L0 = {0.f, 0.f, 0.f, 0.f}, L1 = {0.f, 0.f, 0.f, 0.f};
  const short one_ = (lane == 0 || lane == 32 || lane == 17 || lane == 49) ? (short)0x3F80 : (short)0;
  const bf16x8 aones = {one_, one_, one_, one_, one_, one_, one_, one_};
  int ksrc[NKI], vsrc[NVI];
#pragma unroll
  for (int q = 0; q < NKI; ++q) { const int P = (wave * NKI + q) * 64 + lane, row = P / KCH, cp = P % KCH; ksrc[q] = row * DK + ((cp ^ kswz(row)) << 3); }
#pragma unroll
  for (int q = 0; q < NVI; ++q) { const int P = (wave * NVI + q) * 64 + lane, row = P >> 3, cp = P & 7; vsrc[q] = row * 64 + ((cp ^ (((row >> 1) & 1) << 2)) << 3); }
  auto stage = [&](int t, char* buf) {
#pragma unroll
    for (int q = 0; q < NKI; ++q)
      __builtin_amdgcn_global_load_lds((const unsigned*)(Kh + (size_t)t * KT * DK + ksrc[q]), (unsigned __attribute__((address_space(3)))*)(buf + (wave * NKI + q) * 1024), 16, 0, 0);
#pragma unroll
    for (int q = 0; q < NVI; ++q)
      __builtin_amdgcn_global_load_lds((const unsigned*)(Vh + (size_t)t * KT * 64 + vsrc[q]), (unsigned __attribute__((address_space(3)))*)(buf + KBYTES + (wave * NVI + q) * 1024), 16, 0, 0);
  };
  const int i16 = lane & 15, qq = i16 >> 2, pp = i16 & 3, blk = (lane >> 4) & 1;
  const int sw = (qq >> 1) & 1;
  int vbase[2];
  vbase[0] = KBYTES + (4 * h + qq) * 128 + ((0 ^ sw) << 6) + (16 * blk + 4 * pp) * 2;
  vbase[1] = KBYTES + (4 * h + qq) * 128 + ((1 ^ sw) << 6) + (16 * blk + 4 * pp) * 2;
  constexpr int NT = S / KT;
  stage(0, lds);
  if (wave < 4) __builtin_amdgcn_s_setprio(2); else __builtin_amdgcn_s_setprio(0);
  int cur = 0;
#pragma unroll 1
  for (int j = 0; j < NT; ++j) {
    asm volatile("s_waitcnt vmcnt(0)" ::: "memory");
    asm volatile("s_waitcnt lgkmcnt(0)" ::: "memory"); __builtin_amdgcn_s_barrier(); asm volatile("" ::: "memory");
    char* buf = lds + cur * BUF;
    if (j + 1 < NT) stage(j + 1, lds + (cur ^ 1) * BUF);
#pragma unroll
    for (int kb = 0; kb < KT / 32; ++kb) {
      f32x16 S0, S1;
#pragma unroll
      for (int i = 0; i < 16; ++i) { S0[i] = 0.f; S1[i] = 0.f; }
#pragma unroll
      for (int s = 0; s < NS; ++s) {
        const bf16x8 kf = *(const bf16x8*)(buf + koff(kb * 32 + r32, 2 * s + h));
        S0 = MFMA32(kf, qf[0][s], S0);
        S1 = MFMA32(kf, qf[1][s], S1);
      }
#pragma unroll
      for (int i = 0; i < 16; ++i) S0[i] = __builtin_amdgcn_exp2f(S0[i]);
#pragma unroll
      for (int i = 0; i < 16; ++i) S1[i] = __builtin_amdgcn_exp2f(S1[i]);
      bf16x8 pf0[2], pf1[2];
#pragma unroll
      for (int st = 0; st < 2; ++st) {
        pf0[st] = pack8(S0[8 * st], S0[8 * st + 1], S0[8 * st + 2], S0[8 * st + 3], S0[8 * st + 4], S0[8 * st + 5], S0[8 * st + 6], S0[8 * st + 7]);
        pf1[st] = pack8(S1[8 * st], S1[8 * st + 1], S1[8 * st + 2], S1[8 * st + 3], S1[8 * st + 4], S1[8 * st + 5], S1[8 * st + 6], S1[8 * st + 7]);
      }
#pragma unroll
      for (int st = 0; st < 2; ++st) {
        L0 = __builtin_amdgcn_mfma_f32_16x16x32_bf16(aones, pf0[st], L0, 0, 0, 0);
        L1 = __builtin_amdgcn_mfma_f32_16x16x32_bf16(aones, pf1[st], L1, 0, 0, 0);
      }
#pragma unroll
      for (int st = 0; st < 2; ++st)
#pragma unroll
        for (int db = 0; db < 2; ++db) {
          const char* vp = buf + vbase[db] + (kb * 32 + st * 16) * 128;
          const bf16x8 vf = cat4(trread(vp), trread(vp + 8 * 128));
          O[0][db] = MFMA32(vf, pf0[st], O[0][db]);
          O[1][db] = MFMA32(vf, pf1[st], O[1][db]);
        }
    }
#ifdef SGB
#pragma unroll
    for (int g = 0; g < 16 + 2 * NS; ++g) {
      __builtin_amdgcn_sched_group_barrier(0x008, 1, 0);
      __builtin_amdgcn_sched_group_barrier(0x002, SGB, 0);
      __builtin_amdgcn_sched_group_barrier(0x100, 1, 0);
    }
#endif
    cur ^= 1;
  }
  asm volatile("s_waitcnt lgkmcnt(0)" ::: "memory"); __builtin_amdgcn_s_barrier(); asm volatile("" ::: "memory");
  __builtin_amdgcn_s_setprio(0);
#pragma unroll
  for (int qb = 0; qb < 2; ++qb) {
    const float la_ = __shfl(qb == 0 ? L0[0] : L1[0], r32 & 15, 64), lb_ = __shfl(qb == 0 ? L0[1] : L1[1], r32 & 15, 64);
    const float inv = 1.f / (r32 < 16 ? la_ : lb_);
    const size_t ro = (size_t)(wave * 64 + qb * 32 + r32) * 1024;
#pragma unroll
    for (int db = 0; db < 2; ++db)
#pragma unroll
      for (int g4 = 0; g4 < 4; ++g4) {
        const int d = db * 32 + 8 * g4 + 4 * h;
        const uint2 gg = *(const uint2*)(gate + ro + d);
        st4(yout + ro + d, O[qb][db][4 * g4] * inv * bflo(gg.x), O[qb][db][4 * g4 + 1] * inv * bfhi(gg.x),
            O[qb][db][4 * g4 + 2] * inv * bflo(gg.y), O[qb][db][4 * g4 + 3] * inv * bfhi(gg.y));
      }
  }
}

DI void phase_attn(const KArgs& ka, char* lds) {
  const Params p = make_params(ka);
  const int wave = __builtin_amdgcn_readfirstlane(otid() >> 6);
#ifndef AMASK
#define AMASK 7
#endif
  const int xcd = blockIdx.x & 7, jb = blockIdx.x >> 3, nbx = gridDim.x >> 3;
  for (int q = jb; q < 128; q += nbx) {
    __syncthreads();
    if (q < 48) {
      if (!(AMASK & 1)) continue;
      const int qb = q & 15, bh = xcd + 8 * (q >> 4);
      const size_t ro = (size_t)bh * S;
      const int b = bh / 6, head = bh % 6;
      const size_t tok0 = (size_t)b * S + qb * 512;
      attn_dense_item<96>(p.Qb + (ro + qb * 512) * 96, p.Kb + ro * 96, p.Vb + ro * 64,
                          p.Gate + tok0 * 1024 + 256 + head * 64, p.y + tok0 * 1024 + 256 + head * 64, lds);
    } else if (q < 96) {
      if (!(AMASK & 2)) continue;
      const int q2 = q - 48, qb = q2 & 15, b = xcd >> 1, kvh = xcd & 1, head = kvh * 3 + (q2 >> 4), bh = b * 6 + head;
      const size_t tok0 = (size_t)b * S + qb * 512;
      const size_t kro = (size_t)(b * 2 + kvh) * S;
      attn_dense_item<64>(p.Qc + ((size_t)bh * S + qb * 512) * 64, p.Kc + kro * 64, p.Vc + kro * 64,
                          p.Gate + tok0 * 1024 + 640 + head * 64, p.y + tok0 * 1024 + 640 + head * 64, lds);
    } else if (q >= 112) {
      const int mt = xcd * 16 + (q - 112);
      const ALoadY al{p.y, p.PartA, p.lA, p.Gate};
      int t2 = otid();
#pragma unroll 2
      for (int c = 0; c < 16; ++c) {
        const int idx = t2 + NTH * c, row = mt * 256 + (idx >> 5), kc = (idx & 31) * 8;
        *(bf16x8*)(p.y + (size_t)row * 1024 + kc) = al(row, kc);
      }
    }
  }
}

#define XB_TMO      128
#define XB_XCNT(j)  (256  + 64 * (j))
#define XB_XSUB(j)  (1280 + 64 * (j))
#define XB_XGEN(j)  (2304 + 64 * (j))
#define XB_TOP      3328
#define XB_TOPGEN   3392
#define XCD_BAR_WORDS 3456
#define XB_SPIN_CAP (1u << 22)
DI unsigned xb_ld(unsigned* p) { return __hip_atomic_load(p, __ATOMIC_RELAXED, __HIP_MEMORY_SCOPE_AGENT); }
DI unsigned xb_add(unsigned* p, unsigned v) { return __hip_atomic_fetch_add(p, v, __ATOMIC_RELAXED, __HIP_MEMORY_SCOPE_AGENT); }
DI unsigned xb_xcc_id() { return (unsigned)__builtin_amdgcn_s_getreg((3 << 11) | 20) & 0xFu; }
#define XB_SPIN(cond, bar) do { unsigned _sp = 0; while (cond) { __builtin_amdgcn_s_sleep(1); \
    if ((++_sp & 255u) == 0u) { if (xb_ld(&(bar)[XB_TMO])) break; if (_sp > XB_SPIN_CAP) { atomicAdd(&(bar)[XB_TMO], 1u); break; } } } } while (0)
struct XcdBar { unsigned pk; };
DI XcdBar xcd_setup(unsigned* bar, char* lds) {
  XcdBar b; const unsigned bx = xb_xcc_id();
  unsigned* st = (unsigned*)lds;
  if (threadIdx.x == 0) {
    (void)xb_add(&bar[XB_XCNT(bx)], 1u);
    const unsigned G = gridDim.x;
    unsigned sum, cnt, mine, sp = 0u;
    for (;;) {
      sum = 0u; cnt = 0u; mine = 0u;
#pragma unroll
      for (unsigned j = 0; j < 16; ++j) { const unsigned c = xb_ld(&bar[XB_XCNT(j)]); sum += c; cnt += (c > 0u) ? 1u : 0u; mine = (j == bx) ? c : mine; }
      if (sum == G) break;
      __builtin_amdgcn_s_sleep(1);
      if ((++sp & 255u) == 0u) { if (xb_ld(&bar[XB_TMO])) break; if (sp > XB_SPIN_CAP) { atomicAdd(&bar[XB_TMO], 1u); break; } }
    }
    st[0] = mine > 0u ? mine : 1u; st[1] = cnt > 0u ? cnt : 1u;
  }
  __syncthreads();
  b.pk = __builtin_amdgcn_readfirstlane(bx | (st[0] << 8) | (st[1] << 20));
  __syncthreads();
  return b;
}
DI void xcd_barrier(const XcdBar& b, unsigned* bar, const unsigned epoch) {
  asm volatile("s_waitcnt vmcnt(0)" ::: "memory");
  __syncthreads();
  if (threadIdx.x == 0) {
    __builtin_amdgcn_s_waitcnt(0);
    const unsigned bx = b.pk & 15u, nloc = (b.pk >> 8) & 0xfffu, nx = b.pk >> 20;
    const unsigned old = xb_add(&bar[XB_XSUB(bx)], 1u);
    const unsigned gen = epoch;
    if (old + 1u == (gen + 1u) * nloc) {
      __builtin_amdgcn_fence(__ATOMIC_RELEASE, "agent");
      asm volatile("s_waitcnt vmcnt(0)" ::: "memory");
      const unsigned og = xb_add(&bar[XB_TOP], 1u);
      const unsigned tg = epoch;
      if (og + 1u == (tg + 1u) * nx) xb_add(&bar[XB_TOPGEN], 1u);
      else XB_SPIN(xb_ld(&bar[XB_TOPGEN]) == tg, bar);
      __builtin_amdgcn_fence(__ATOMIC_ACQUIRE, "agent");
      xb_add(&bar[XB_XGEN(bx)], 1u);
      asm volatile("s_waitcnt vmcnt(0)" ::: "memory");
    } else {
      XB_SPIN(xb_ld(&bar[XB_XGEN(bx)]) == gen, bar);
      __builtin_amdgcn_fence(__ATOMIC_ACQUIRE, "agent");
      asm volatile("s_waitcnt vmcnt(0)" ::: "memory");
    }
  }
  __syncthreads();
}

__global__ __launch_bounds__(512, 2) void mega(KArgs ka, int ph_lo, int ph_hi, int coop) {
  __shared__ __attribute__((aligned(16))) char lds[163840];
  XcdBar xb{};
  if (coop) xb = xcd_setup((unsigned*)((char*)ka.ws + OFF_bar), lds);
  for (int ph = ph_lo; ph < ph_hi; ++ph) {
#ifndef ONLY
#define ONLY -1
#endif
    if (ph == 0) { if (ONLY < 0 || ONLY == 0) phaseW(ka, lds); }
    else {
      const int l = (ph - 1) >> 2, k = (ph - 1) & 3;
      if (k == 0) { if (ONLY < 0 || ONLY == 1) phase_gemm1(ka, l, lds); }
      else if (k == 1) { if (ONLY < 0 || ONLY == 2) phase_mla_up(ka, l, lds); }
      else if (k == 2) { if (ONLY < 0 || ONLY == 3) phase_attn(ka, lds);
      }
      else { if (ONLY < 0 || ONLY == 4) phase_outproj(ka, l, lds); }
    }
    if (coop && ph + 1 < ph_hi) { if (coop == 2) cg::this_grid().sync(); else xcd_barrier(xb, (unsigned*)((char*)ka.ws + OFF_bar), (unsigned)(ph - ph_lo)); }
  }
}

extern "C" void kernel_launch(void* const* d_in, const int* in_sizes, int n_in, void* d_out, int out_size, void* d_ws, size_t ws_size,
                              hipStream_t stream) {
  KArgs p{};
  for (int i = 0; i < 14; ++i) p.in[i] = (const float AS1*)d_in[i];
  p.out = (float AS1*)d_out; p.ws = (char AS1*)d_ws;
  if (WS_TOTAL > ws_size) { fprintf(stderr, "workspace too small: need %zu have %zu\n", (size_t)WS_TOTAL, ws_size); return; }

  static int grid_blocks = 0;
  if (!grid_blocks) {
    int dev = 0, cus = 0, per_cu = 0;
    hipGetDevice(&dev);
    hipDeviceGetAttribute(&cus, hipDeviceAttributeMultiprocessorCount, dev);
    hipOccupancyMaxActiveBlocksPerMultiprocessor(&per_cu, mega, NTH, 0);
    per_cu = 1;
    grid_blocks = cus * per_cu;
  }
#if COOP
  hipMemsetAsync((char*)d_ws + OFF_bar, 0, 16384, stream);
  int lo = 0, hi = NPHASE, coop = 1;
  void* args[] = {&p, &lo, &hi, &coop};
  hipError_t e = hipLaunchCooperativeKernel((void*)mega, dim3(grid_blocks), dim3(NTH), args, 0, stream);
  if (e != hipSuccess) fprintf(stderr, "cooperative launch failed: %s (grid %d)\n", hipGetErrorString(e), grid_blocks);
#else
  for (int ph = 0; ph < NPHASE; ++ph) hipLaunchKernelGGL(mega, dim3(grid_blocks), dim3(NTH), 0, stream, p, ph, ph + 1, 0);
#endif
}
```
